# Optimizing an MI355X kernel written in HIP

```python
import math
import jax, jax.numpy as jnp
from jax import lax
import numpy as np

D_MODEL = 1024
BATCH = 1
SEQ = 16384
DEPTH = 1
DEC_BATCH = 32
DEC_SEQ = 64
PAST_LEN = 4096

CHUNK = 64
QBLOCK = 128
MIX_WIDTH = D_MODEL
FOX_HEADS = 8
FOX_HD = MIX_WIDTH // 2 // FOX_HEADS
FOX_W = FOX_HEADS * FOX_HD
DIFF_HEADS = 4
DIFF_HD = MIX_WIDTH // 2 // (2 * DIFF_HEADS)
DIFF_W = DIFF_HEADS * 2 * DIFF_HD
NUM_BUCKETS = 32
MAX_DISTANCE = 128
EPS = 1e-6
NEG_INF = -1e30
IN_SPLITS = (FOX_W, FOX_W, FOX_W, FOX_HEADS, FOX_W, DIFF_W, DIFF_W, DIFF_W, DIFF_W)
IN_COLS = sum(IN_SPLITS)
SPLIT_POINTS = [int(c) for c in np.cumsum(IN_SPLITS)[:-1]]

kernel_name = "hybrid_fox_diffattn_streaming_step"


def rmsnorm(x, g):
    xf = x.astype(jnp.float32)
    y = xf * lax.rsqrt(jnp.mean(xf * xf, axis=-1, keepdims=True) + EPS)
    return (y * g.astype(jnp.float32)).astype(x.dtype)


def t5_bucket(rel):
    half = NUM_BUCKETS // 2
    max_exact = half // 2
    ret = jnp.where(rel > 0, half, 0)
    n = jnp.abs(rel)
    nf = jnp.maximum(n, 1).astype(jnp.float32)
    large = max_exact + (jnp.log(nf / max_exact) / math.log(MAX_DISTANCE / max_exact)
                         * (half - max_exact)).astype(jnp.int32)
    large = jnp.minimum(large, half - 1)
    return ret + jnp.where(n < max_exact, n, large)


def _to_blocks(a, qb):
    b, sq = a.shape[:2]
    a = a.reshape((b, sq // qb, qb) + a.shape[2:])
    return jnp.moveaxis(a, 1, 0)


def _from_blocks(a):
    a = jnp.moveaxis(a, 0, 1)
    return a.reshape((a.shape[0], a.shape[1] * a.shape[2]) + a.shape[3:])


def fox_attention(q, k, v, cum_q, cum_k, q_pos, k_pos):
    qb = min(QBLOCK, q.shape[1])
    scale = FOX_HD ** -0.5
    cum_kT = jnp.swapaxes(cum_k, 1, 2)

    def block(args):
        qi, ci, pi = args
        s = jnp.einsum('bqhd,bkhd->bhqk', qi, k).astype(jnp.float32) * scale
        s = s + jnp.swapaxes(ci, 1, 2)[..., :, None] - cum_kT[..., None, :]
        s = jnp.where(k_pos[None, :] <= pi[:, None], s, NEG_INF)
        p = jax.nn.softmax(s, axis=-1).astype(v.dtype)
        return jnp.einsum('bhqk,bkhd->bqhd', p, v)

    out = lax.map(block, (_to_blocks(q, qb), _to_blocks(cum_q, qb), q_pos.reshape(-1, qb)))
    return _from_blocks(out)


def diff_attention(q1, q2, k1, k2, v, lam, rel_bias, q_pos, k_pos):
    qb = min(QBLOCK, q1.shape[1])
    scale = DIFF_HD ** -0.5
    k_chunk = k_pos // CHUNK

    def block(args):
        q1i, q2i, pi = args
        bias = jnp.moveaxis(rel_bias[t5_bucket(k_pos[None, :] - pi[:, None])], -1, 0).astype(jnp.float32)
        mask = k_chunk[None, :] <= (pi // CHUNK)[:, None]

        def probs(qi, ki):
            s = jnp.einsum('bqhd,bkhd->bhqk', qi, ki).astype(jnp.float32) * scale + bias
            return jax.nn.softmax(jnp.where(mask, s, NEG_INF), axis=-1)

        p = probs(q1i, k1) - lam * probs(q2i, k2)
        return jnp.einsum('bhqk,bkhd->bqhd', p.astype(v.dtype), v)

    out = lax.map(block, (_to_blocks(q1, qb), _to_blocks(q2, qb), q_pos.reshape(-1, qb)))
    return _from_blocks(out)


def mixer_layer(x, past, g_pre, w_in, b_f, lq1, lk1, lq2, lk2, subln_g, w_out, g_post, rel_bias, layer_idx):
    b, s, _ = x.shape
    h = rmsnorm(x, g_pre)
    proj = jnp.einsum('bsd,dc->bsc', h, w_in)
    fq, fk, fv, ff, fg, dq, dk, dv, dg = jnp.split(proj, SPLIT_POINTS, axis=-1)
    fq = fq.reshape(b, s, FOX_HEADS, FOX_HD)
    fk = fk.reshape(b, s, FOX_HEADS, FOX_HD)
    fv = fv.reshape(b, s, FOX_HEADS, FOX_HD)
    logf = jax.nn.log_sigmoid(ff.astype(jnp.float32) + b_f.astype(jnp.float32))
    dq = dq.reshape(b, s, DIFF_HEADS, 2 * DIFF_HD)
    dk = dk.reshape(b, s, DIFF_HEADS, 2 * DIFF_HD)
    dv = dv.reshape(b, s, DIFF_HEADS, 2 * DIFF_HD)
    new_rows = (fk, fv, logf.astype(x.dtype), dk, dv)

    if past is None:
        p_len = 0
        fk_all, fv_all, logf_all, dk_all, dv_all = fk, fv, logf, dk, dv
    else:
        pk, pv, plogf, pdk, pdv = past
        p_len = pk.shape[1]
        fk_all = jnp.concatenate([pk.astype(fk.dtype), fk], axis=1)
        fv_all = jnp.concatenate([pv.astype(fv.dtype), fv], axis=1)
        logf_all = jnp.concatenate([plogf.astype(jnp.float32), logf], axis=1)
        dk_all = jnp.concatenate([pdk.astype(dk.dtype), dk], axis=1)
        dv_all = jnp.concatenate([pdv.astype(dv.dtype), dv], axis=1)
    k_pos = jnp.arange(p_len + s, dtype=jnp.int32)
    q_pos = k_pos[p_len:]

    cum = jnp.cumsum(logf_all, axis=1)
    fox_o = fox_attention(fq, fk_all, fv_all, cum[:, p_len:], cum, q_pos, k_pos).reshape(b, s, FOX_W)

    lam_init = 0.8 - 0.6 * math.exp(-0.3 * layer_idx)
    lam = (jnp.exp(jnp.sum(lq1.astype(jnp.float32) * lk1.astype(jnp.float32)))
           - jnp.exp(jnp.sum(lq2.astype(jnp.float32) * lk2.astype(jnp.float32))) + lam_init)
    diff_o = diff_attention(dq[..., :DIFF_HD], dq[..., DIFF_HD:], dk_all[..., :DIFF_HD], dk_all[..., DIFF_HD:],
                            dv_all, lam, rel_bias, q_pos, k_pos)
    diff_o = (rmsnorm(diff_o, subln_g) * (1.0 - lam_init)).reshape(b, s, DIFF_W)

    mixed = jnp.concatenate([fox_o * jax.nn.silu(fg), diff_o * jax.nn.silu(dg)], axis=-1)
    out = jnp.einsum('bsc,cd->bsd', mixed, w_out)
    return x + rmsnorm(out, g_post), new_rows


def setup_inputs(seed: int = 0) -> dict:
    key = jax.random.key(seed)
    ks = jax.random.split(key, 20)
    f32 = jnp.float32
    cache_shape_f = (DEPTH, DEC_BATCH, PAST_LEN, FOX_HEADS, FOX_HD)
    cache_shape_d = (DEPTH, DEC_BATCH, PAST_LEN, DIFF_HEADS, 2 * DIFF_HD)
    return {
        "x_prompt": jax.random.normal(ks[0], (BATCH, SEQ, D_MODEL), f32),
        "x_sample": jax.random.normal(ks[1], (DEC_BATCH, DEC_SEQ, D_MODEL), f32),
        "cache_fox_k": jax.random.normal(ks[2], cache_shape_f, f32),
        "cache_fox_v": jax.random.normal(ks[3], cache_shape_f, f32),
        "cache_fox_logf": jax.nn.log_sigmoid(3.0 + jax.random.normal(ks[4], (DEPTH, DEC_BATCH, PAST_LEN, FOX_HEADS), f32)),
        "cache_diff_k": jax.random.normal(ks[5], cache_shape_d, f32),
        "cache_diff_v": jax.random.normal(ks[6], cache_shape_d, f32),
        "norm_pre_g": 1.0 + 0.02 * jax.random.normal(ks[7], (DEPTH, D_MODEL), f32),
        "w_in": jax.random.normal(ks[8], (DEPTH, D_MODEL, IN_COLS), f32) * D_MODEL ** -0.5,
        "forget_bias": 3.0 + 0.1 * jax.random.normal(ks[9], (DEPTH, FOX_HEADS), f32),
        "lambda_q1": 0.1 * jax.random.normal(ks[10], (DEPTH, DIFF_HD), f32),
        "lambda_k1": 0.1 * jax.random.normal(ks[11], (DEPTH, DIFF_HD), f32),
        "lambda_q2": 0.1 * jax.random.normal(ks[12], (DEPTH, DIFF_HD), f32),
        "lambda_k2": 0.1 * jax.random.normal(ks[13], (DEPTH, DIFF_HD), f32),
        "subln_g": 1.0 + 0.02 * jax.random.normal(ks[14], (DEPTH, 2 * DIFF_HD), f32),
        "w_out": jax.random.normal(ks[15], (DEPTH, MIX_WIDTH, D_MODEL), f32) * MIX_WIDTH ** -0.5,
        "norm_post_g": 1.0 + 0.02 * jax.random.normal(ks[16], (DEPTH, D_MODEL), f32),
        "rel_bias": 0.5 * jax.random.normal(ks[17], (NUM_BUCKETS, DIFF_HEADS), f32),
    }


def reference(x_prompt, x_sample, cache_fox_k, cache_fox_v, cache_fox_logf, cache_diff_k, cache_diff_v,
              norm_pre_g, w_in, forget_bias, lambda_q1, lambda_k1, lambda_q2, lambda_k2, subln_g, w_out,
              norm_post_g, rel_bias):
    y_p = x_prompt
    y_s = x_sample
    rows_p = []
    rows_s = []
    for l in range(DEPTH):
        params = (norm_pre_g[l], w_in[l], forget_bias[l], lambda_q1[l], lambda_k1[l], lambda_q2[l],
                  lambda_k2[l], subln_g[l], w_out[l], norm_post_g[l], rel_bias)
        y_p, new_p = mixer_layer(y_p, None, *params, l)
        past = (cache_fox_k[l], cache_fox_v[l], cache_fox_logf[l], cache_diff_k[l], cache_diff_v[l])
        y_s, new_s = mixer_layer(y_s, past, *params, l)
        rows_p.append(new_p)
        rows_s.append(new_s)
    fox_k_p = jnp.stack([r[0] for r in rows_p], axis=0)
    fox_v_p = jnp.stack([r[1] for r in rows_p], axis=0)
    fox_logf_p = jnp.stack([r[2] for r in rows_p], axis=0)
    diff_k_p = jnp.stack([r[3] for r in rows_p], axis=0)
    diff_v_p = jnp.stack([r[4] for r in rows_p], axis=0)
    fox_k_s = jnp.stack([r[0] for r in rows_s], axis=0)
    fox_v_s = jnp.stack([r[1] for r in rows_s], axis=0)
    fox_logf_s = jnp.stack([r[2] for r in rows_s], axis=0)
    diff_k_s = jnp.stack([r[3] for r in rows_s], axis=0)
    diff_v_s = jnp.stack([r[4] for r in rows_s], axis=0)
    return (y_p, y_s, fox_k_p, fox_v_p, fox_logf_p, diff_k_p, diff_v_p,
            fox_k_s, fox_v_s, fox_logf_s, diff_k_s, diff_v_s)
```

```cpp
#include <hip/hip_runtime.h>
#include <cstdio>
#include <cstdint>
#define GAS __attribute__((address_space(1)))
#define LAS __attribute__((address_space(3)))
namespace pg8 {
#define PG8_LAS __attribute__((address_space(3)))
typedef unsigned short bf16_t;
typedef short bf16x8 __attribute__((ext_vector_type(8)));
typedef float f32x4 __attribute__((ext_vector_type(4)));
typedef unsigned u32x4 __attribute__((ext_vector_type(4)));
constexpr int BM = 256, BK = 64, HALF = 128, HTB = HALF * BK * 2  , STAGE_BYTES = 8 * HTB, NXCD = 8, WGM = 8;

__host__ __device__ __forceinline__ int lds_byte(int r, int c) { const int st = (r >> 4) * 2 + (c >> 5), rr = r & 15, cc = c & 31, ob = rr * 64 + cc * 2; return st * 1024 + (ob ^ (((ob >> 9) & 1) << 5)); }
__host__ __device__ __forceinline__ void stage_rc(int b, int& R, int& C) { const int st = b / 1024, sb = b % 1024, swz = sb ^ (((sb >> 9) & 1) << 5); R = (st >> 1) * 16 + swz / 64; C = (st & 1) * 32 + (swz % 64) / 2; }
__host__ __device__ __forceinline__ int perm32(int rho) { const int n = rho >> 4, i = rho & 15; return 8 * (i >> 2) + 4 * n + (i & 3); }

struct Unit { int pm, pn; };
struct Gemm { const bf16_t* A; const bf16_t* Bt; int M, N, K; };

struct StaticOrder {
    int nM, nN, nwg, G, c;
    __host__ __device__ void init(int M, int N, int G_, int c_) { nM = M / BM; nN = N / BM; nwg = nM * nN; G = G_; c = c_; }
    __host__ __device__ bool next(int i, Unit& u) const {
        const long L = (long)i * G + c; if (L >= nwg) return false;
        int wgid = (int)L; { const int q = nwg / NXCD, r = nwg % NXCD, xcd = wgid % NXCD, off = wgid / NXCD; wgid = (xcd < r ? xcd * (q + 1) : r * (q + 1) + (xcd - r) * q) + off; }
        const int nig = WGM * nN, gid = wgid / nig, fm = gid * WGM, gsz = (nM - fm) < WGM ? (nM - fm) : WGM;
        u.pm = fm + ((wgid % nig) % gsz); u.pn = (wgid % nig) / gsz; return true;
    }
    __device__ __forceinline__ void a_ready(const Unit&) const {}
    __device__ __forceinline__ void done(const Unit&) const {}
};

__device__ __forceinline__ unsigned cvt_pk_bf16(float lo, float hi) { unsigned r; asm volatile("v_cvt_pk_bf16_f32 %0, %1, %2" : "=v"(r) : "v"(lo), "v"(hi)); return r; }
typedef float f32x2 __attribute__((ext_vector_type(2)));
typedef float f32x2 __attribute__((ext_vector_type(2)));
__device__ __forceinline__ float silu_f(float x) { return x * __builtin_amdgcn_rcpf(1.0f + __builtin_amdgcn_exp2f(-1.4426950408889634f * x)); }
struct EpiIn {
    static constexpr bool PERM = true, AFTER_DRAIN = false;
    bf16_t* segbase; size_t segstride;
    float* out;
    float c2;
    __device__ __forceinline__ void operator()(const f32x4 (&acc)[2][2][4][2], const Unit& u, int wr, int wc, int fr, int fq) const {
        const int seg = u.pn >> 1;
        const int col0 = (u.pn & 1) * 256 + wc * 32 + 8 * fq;
        const int row0 = u.pm * BM + wr * 64 + fr;
        bf16_t* bb = segbase + (size_t)seg * segstride;
        const bool is_s = (u.pm >= 64);
        const int mode = (seg == 0 || seg == 4) ? 0 : ((seg == 3 || seg == 7) ? 2 : 1);
        if (mode == 1) {
            const size_t offp = seg == 1 ? (size_t)18874368 : seg == 2 ? (size_t)27262976 : seg == 5 ? (size_t)35782656 : (size_t)44171264;
            const size_t offs = seg == 1 ? (size_t)52559872 : seg == 2 ? (size_t)53608448 : seg == 5 ? (size_t)54673408 : (size_t)55721984;
            float* fb = out + (is_s ? offs : offp);
            const int rsub = is_s ? 16384 : 0;
#pragma unroll
            for (int ai = 0; ai < 2; ++ai)
#pragma unroll
                for (int m = 0; m < 4; ++m) { const int row = row0 + ai * HALF + m * 16;
                    bf16_t* rowp = bb + (size_t)row * 512 + col0; float* frow = fb + (size_t)(row - rsub) * 512 + col0;
#pragma unroll
                    for (int bj = 0; bj < 2; ++bj) { const f32x4 v0 = acc[ai][bj][m][0], v1 = acc[ai][bj][m][1];
                        *(f32x4*)(frow + bj * HALF) = v0; *(f32x4*)(frow + bj * HALF + 4) = v1;
                        u32x4 w; w.x = cvt_pk_bf16(v0[0], v0[1]); w.y = cvt_pk_bf16(v0[2], v0[3]); w.z = cvt_pk_bf16(v1[0], v1[1]); w.w = cvt_pk_bf16(v1[2], v1[3]);
                        *(u32x4*)(rowp + bj * HALF) = w; } }
        } else if (mode == 0) {
            const float sc = c2;
#pragma unroll
            for (int ai = 0; ai < 2; ++ai)
#pragma unroll
                for (int m = 0; m < 4; ++m) { const int row = row0 + ai * HALF + m * 16; bf16_t* rowp = bb + (size_t)row * 512 + col0;
#pragma unroll
                    for (int bj = 0; bj < 2; ++bj) { const f32x4 v0 = acc[ai][bj][m][0] * sc, v1 = acc[ai][bj][m][1] * sc;
                        u32x4 w; w.x = cvt_pk_bf16(v0[0], v0[1]); w.y = cvt_pk_bf16(v0[2], v0[3]); w.z = cvt_pk_bf16(v1[0], v1[1]); w.w = cvt_pk_bf16(v1[2], v1[3]);
                        *(u32x4*)(rowp + bj * HALF) = w; } }
        } else {
#pragma unroll
            for (int ai = 0; ai < 2; ++ai)
#pragma unroll
                for (int m = 0; m < 4; ++m) { const int row = row0 + ai * HALF + m * 16; bf16_t* rowp = bb + (size_t)row * 512 + col0;
#pragma unroll
                    for (int bj = 0; bj < 2; ++bj) { const f32x4 a0 = acc[ai][bj][m][0], a1 = acc[ai][bj][m][1];
                        u32x4 w; w.x = cvt_pk_bf16(silu_f(a0[0]), silu_f(a0[1])); w.y = cvt_pk_bf16(silu_f(a0[2]), silu_f(a0[3]));
                        w.z = cvt_pk_bf16(silu_f(a1[0]), silu_f(a1[1])); w.w = cvt_pk_bf16(silu_f(a1[2]), silu_f(a1[3]));
                        *(u32x4*)(rowp + bj * HALF) = w; } }
        }
    }
};
struct EpiOut {
    static constexpr bool PERM = false, AFTER_DRAIN = false;
    float* outf; float* ss;
    __device__ __forceinline__ void operator()(const f32x4 (&acc)[2][2][4][2], const Unit& u, int wr, int wc, int fr, int fq) const {
        const int col0 = u.pn * BM + wc * 32 + 4 * fq;
#pragma unroll
        for (int ai = 0; ai < 2; ++ai)
#pragma unroll
            for (int m = 0; m < 4; ++m) { const int row = u.pm * BM + ai * HALF + wr * 64 + m * 16 + fr; float* rp = outf + (size_t)row * 1024 + col0; float s = 0.f;
#pragma unroll
                for (int bj = 0; bj < 2; ++bj)
#pragma unroll
                    for (int n = 0; n < 2; ++n) { const f32x4 v = acc[ai][bj][m][n]; *(f32x4*)(rp + bj * HALF + n * 16) = v; s += (v[0] * v[0] + v[1] * v[1]) + (v[2] * v[2] + v[3] * v[3]); }
                s += __shfl_xor(s, 16); s += __shfl_xor(s, 32);
                if (fq == 0) ss[(size_t)row * 16 + u.pn * 4 + wc] = s; }
    }
};
template <class Epi, class Sched, bool ALIGN_EPI = false, bool SP2 = false>
__device__ __forceinline__ void gemm_phase(PG8_LAS unsigned char* lds, const Gemm g, const Sched& S, const Epi& E) {
    const int tid = threadIdx.x, wid = __builtin_amdgcn_readfirstlane(tid >> 6), lane = tid & 63, wr = wid >> 2, wc = wid & 3, fr = lane & 15, fq = lane >> 4;
    const int K = g.K, nt = K / BK;
    unsigned voffA[2], voffB[2];
#pragma unroll
    for (int i = 0; i < 2; ++i) { int R, C; stage_rc(tid * 16 + i * 8192, R, C); const int Rb = Epi::PERM ? ((R & ~31) + perm32(R & 31)) : R;
        voffA[i] = (unsigned)(R * K + C) * 2u; voffB[i] = (unsigned)(Rb * K + C) * 2u; }
    const size_t kstep = (size_t)(BK * 2);
    const size_t hstep = (size_t)HALF * K * 2;
    const size_t tstep = 2 * hstep;
    const unsigned ldsw = (unsigned)wid * 1024u;
    const int aoff = lds_byte(wr * 64 + fr, fq * 8), boff = lds_byte(wc * 32 + fr, fq * 8);
#define PG8_SA(b, h) (((b) * 2 + (h)) * HTB)
#define PG8_SB(b, h) ((4 + (b) * 2 + (h)) * HTB)
#define PG8_STAGE(bufoff, gbase, voff) do { _Pragma("unroll") for (int _i = 0; _i < 2; ++_i) \
        __builtin_amdgcn_global_load_lds((const unsigned*)((const char*)(gbase) + (voff)[_i]), (PG8_LAS unsigned*)(lds + (bufoff) + ldsw + _i * 8192), 16, 0, 0); } while (0)
#define PG8_LDA(dst, b, h) do { _Pragma("unroll") for (int m = 0; m < 4; ++m) _Pragma("unroll") for (int k = 0; k < 2; ++k) dst[m][k] = *(const PG8_LAS bf16x8*)(lds + PG8_SA(b, h) + aoff + m * 2048 + k * 1024); } while (0)
#define PG8_LDB(dst, b, h) do { _Pragma("unroll") for (int n = 0; n < 2; ++n) _Pragma("unroll") for (int k = 0; k < 2; ++k) dst[n][k] = *(const PG8_LAS bf16x8*)(lds + PG8_SB(b, h) + boff + n * 2048 + k * 1024); } while (0)
#define PG8_MMA(ai, bj, At, Bt) do { __builtin_amdgcn_s_setprio(1); _Pragma("unroll") for (int m = 0; m < 4; ++m) _Pragma("unroll") for (int n = 0; n < 2; ++n) _Pragma("unroll") for (int k = 0; k < 2; ++k) \
        acc[ai][bj][m][n] = __builtin_amdgcn_mfma_f32_16x16x32_bf16(Bt[n][k], At[m][k], acc[ai][bj][m][n], 0, 0, 0); __builtin_amdgcn_s_setprio(0); } while (0)
#define PG8_WAIT_V(n) asm volatile("s_waitcnt vmcnt(" #n ")" ::: "memory")
#define PG8_WAIT_L(n) asm volatile("s_waitcnt lgkmcnt(" #n ")" ::: "memory")
#define PG8_BAR __builtin_amdgcn_s_barrier()
#define PG8_SCHED __builtin_amdgcn_sched_barrier(0)
    Unit cur, nxt; int ui = 0;
    if (!S.next(0, cur)) return;
    f32x4 acc[2][2][4][2];
#pragma unroll
    for (int a = 0; a < 2; ++a)
#pragma unroll
        for (int b = 0; b < 2; ++b)
#pragma unroll
            for (int m = 0; m < 4; ++m)
#pragma unroll
                for (int n = 0; n < 2; ++n) acc[a][b][m][n] = (f32x4){0.f, 0.f, 0.f, 0.f};
    bf16x8 At[4][2], B0[2][2], B1[2][2];
    const char* cA = (const char*)g.A + (size_t)cur.pm * tstep; const char* cB = (const char*)g.Bt + (size_t)cur.pn * tstep;
    S.a_ready(cur);
    if constexpr (SP2) {
        PG8_STAGE(PG8_SB(0, 0), cB, voffB); PG8_STAGE(PG8_SB(0, 1), cB + hstep, voffB); PG8_STAGE(PG8_SA(0, 0), cA, voffA); PG8_STAGE(PG8_SA(0, 1), cA + hstep, voffA);
        if (wr == 1) PG8_BAR;
        PG8_WAIT_V(2); PG8_BAR;
        PG8_STAGE(PG8_SB(1, 0), cB + kstep, voffB); PG8_STAGE(PG8_SA(1, 0), cA + kstep, voffA); PG8_STAGE(PG8_SB(1, 1), cB + hstep + kstep, voffB);
        PG8_WAIT_V(6); PG8_BAR;
    } else {
        PG8_STAGE(PG8_SB(0, 0), cB, voffB); PG8_STAGE(PG8_SA(0, 0), cA, voffA); PG8_STAGE(PG8_SB(0, 1), cB + hstep, voffB); PG8_STAGE(PG8_SA(0, 1), cA + hstep, voffA);
        if (wr == 1) PG8_BAR;
        PG8_WAIT_V(4); PG8_BAR;
        PG8_STAGE(PG8_SB(1, 0), cB + kstep, voffB); PG8_STAGE(PG8_SA(1, 0), cA + kstep, voffA); PG8_STAGE(PG8_SB(1, 1), cB + hstep + kstep, voffB);
        PG8_WAIT_V(6); PG8_BAR;
    }
    for (;;) {
        const bool has_next = S.next(ui + 1, nxt);
        const char* nA = has_next ? (const char*)g.A + (size_t)nxt.pm * tstep : cA; const char* nB = has_next ? (const char*)g.Bt + (size_t)nxt.pn * tstep : cB;
        for (int t = 0; t < nt; t += 2) {
            const bool last = (t == nt - 2);
            const char* a1 = cA + (size_t)(t + 1) * kstep;
            const char* a2 = last ? nA : cA + (size_t)(t + 2) * kstep; const char* b2 = last ? nB : cB + (size_t)(t + 2) * kstep;
            const char* a3 = a2 + kstep; const char* b3 = b2 + kstep;
            if (last && has_next) S.a_ready(nxt);
            if constexpr (SP2) {
            PG8_LDB(B0, 0, 0); PG8_LDB(B1, 0, 1); PG8_SCHED; PG8_LDA(At, 0, 0); PG8_STAGE(PG8_SA(1, 1), a1 + hstep, voffA);
            PG8_WAIT_V(8); PG8_WAIT_L(0); PG8_BAR; PG8_MMA(0, 0, At, B0); PG8_MMA(0, 1, At, B1); PG8_BAR; PG8_SCHED;
            PG8_LDA(At, 0, 1); PG8_STAGE(PG8_SB(0, 0), b2, voffB); PG8_STAGE(PG8_SB(0, 1), b2 + hstep, voffB); PG8_STAGE(PG8_SA(0, 0), a2, voffA);
            PG8_WAIT_V(8); PG8_WAIT_L(0); PG8_BAR; PG8_MMA(1, 0, At, B0); PG8_MMA(1, 1, At, B1); PG8_BAR; PG8_SCHED;
            PG8_LDB(B0, 1, 0); PG8_LDB(B1, 1, 1); PG8_SCHED; PG8_LDA(At, 1, 0); PG8_STAGE(PG8_SA(0, 1), a2 + hstep, voffA);
            PG8_WAIT_V(8); PG8_WAIT_L(0); PG8_BAR; PG8_MMA(0, 0, At, B0); PG8_MMA(0, 1, At, B1); PG8_BAR; PG8_SCHED;
            PG8_LDA(At, 1, 1); PG8_STAGE(PG8_SB(1, 0), b3, voffB); PG8_STAGE(PG8_SB(1, 1), b3 + hstep, voffB); PG8_STAGE(PG8_SA(1, 0), a3, voffA);
            PG8_WAIT_V(8); PG8_WAIT_L(0); PG8_BAR; PG8_MMA(1, 0, At, B0); PG8_MMA(1, 1, At, B1); PG8_BAR; PG8_SCHED;
            } else {
            PG8_LDB(B0, 0, 0); PG8_SCHED; PG8_LDA(At, 0, 0); PG8_STAGE(PG8_SA(1, 1), a1 + hstep, voffA);
            PG8_WAIT_L(8); PG8_BAR; PG8_WAIT_L(0); PG8_MMA(0, 0, At, B0); PG8_BAR; PG8_SCHED;
            PG8_LDB(B1, 0, 1); PG8_STAGE(PG8_SB(0, 0), b2, voffB);
            PG8_BAR; PG8_WAIT_L(0); PG8_MMA(0, 1, At, B1); PG8_BAR;
            PG8_LDA(At, 0, 1); PG8_STAGE(PG8_SA(0, 0), a2, voffA);
            PG8_BAR; PG8_WAIT_L(0); PG8_MMA(1, 0, At, B0); PG8_BAR; PG8_SCHED;
            PG8_STAGE(PG8_SB(0, 1), b2 + hstep, voffB);
            PG8_WAIT_V(6); PG8_BAR; PG8_MMA(1, 1, At, B1); PG8_BAR;
            PG8_LDB(B0, 1, 0); PG8_SCHED; PG8_LDA(At, 1, 0); PG8_STAGE(PG8_SA(0, 1), a2 + hstep, voffA);
            PG8_WAIT_L(8); PG8_BAR; PG8_WAIT_L(0); PG8_MMA(0, 0, At, B0); PG8_BAR; PG8_SCHED;
            PG8_LDB(B1, 1, 1); PG8_STAGE(PG8_SB(1, 0), b3, voffB);
            PG8_BAR; PG8_WAIT_L(0); PG8_MMA(0, 1, At, B1); PG8_BAR;
            PG8_LDA(At, 1, 1); PG8_STAGE(PG8_SA(1, 0), a3, voffA);
            PG8_BAR; PG8_WAIT_L(0); PG8_MMA(1, 0, At, B0); PG8_BAR; PG8_SCHED;
            PG8_STAGE(PG8_SB(1, 1), b3 + hstep, voffB);
            PG8_WAIT_V(6); PG8_BAR; PG8_MMA(1, 1, At, B1); PG8_BAR;
            }
        }
        if constexpr (ALIGN_EPI) { if (wr == 0) PG8_BAR; }
        if constexpr (!Epi::AFTER_DRAIN) { E(acc, cur, wr, wc, fr, fq); S.done(cur); }
        if (!has_next) break;
#pragma unroll
        for (int a = 0; a < 2; ++a)
#pragma unroll
            for (int b = 0; b < 2; ++b)
#pragma unroll
                for (int m = 0; m < 4; ++m)
#pragma unroll
                    for (int n = 0; n < 2; ++n) acc[a][b][m][n] = (f32x4){0.f, 0.f, 0.f, 0.f};
        cur = nxt; cA = nA; cB = nB; ++ui;
        if constexpr (ALIGN_EPI) { if (wr == 1) PG8_BAR; }
    }
    PG8_WAIT_V(0);
    if constexpr (!ALIGN_EPI) { if (wr == 0) PG8_BAR; }
    PG8_BAR;
    if constexpr (Epi::AFTER_DRAIN) { E.fused(acc, cur, wr, wc, fr, fq, lds, wid, lane); S.done(cur); }
#undef PG8_SA
#undef PG8_SB
#undef PG8_STAGE
#undef PG8_LDA
#undef PG8_LDB
#undef PG8_MMA
#undef PG8_WAIT_V
#undef PG8_WAIT_L
#undef PG8_BAR
#undef PG8_SCHED
}
}
#define XB_TMO      128
#define XB_XCNT(j)  (256  + 64 * (j))
#define XB_XSUB(j)  (1280 + 64 * (j))
#define XB_XGEN(j)  (2304 + 64 * (j))
#define XB_TOP      3328
#define XB_TOPGEN   3392
#define XCD_BAR_WORDS 3456
#define XB_SPIN_CAP (1u << 18)

__device__ __forceinline__ unsigned xb_ld(unsigned* p)              { return __hip_atomic_load(p, __ATOMIC_RELAXED, __HIP_MEMORY_SCOPE_AGENT); }
__device__ __forceinline__ unsigned xb_add(unsigned* p, unsigned v) { return __hip_atomic_fetch_add(p, v, __ATOMIC_RELAXED, __HIP_MEMORY_SCOPE_AGENT); }
__device__ __forceinline__ unsigned xb_xcc_id() { return (unsigned)__builtin_amdgcn_s_getreg((3 << 11) | 20) & 0xFu; }
#define XB_SPIN(cond, bar) do { unsigned _sp = 0; while (cond) { __builtin_amdgcn_s_sleep(1); \
    if ((++_sp & 255u) == 0u) { if (xb_ld(&(bar)[XB_TMO])) break; if (_sp > XB_SPIN_CAP) { atomicAdd(&(bar)[XB_TMO], 1u); break; } } } } while (0)

struct XcdBarrier {
    unsigned* bar; unsigned x;
    volatile LAS unsigned* st;
};

__device__ __forceinline__ XcdBarrier xcd_barrier_post(unsigned* bar, volatile LAS unsigned* st) {
    XcdBarrier b; b.bar = bar; b.x = xb_xcc_id(); b.st = st;
    if (threadIdx.x == 0) (void)xb_add(&bar[XB_XCNT(b.x)], 1u);
    return b;
}
__device__ __forceinline__ void xcd_barrier_complete(unsigned* bar, unsigned x, unsigned& nloc, unsigned& nx) {
    const unsigned G = gridDim.x * gridDim.y * gridDim.z;
    unsigned sum, cnt, mine, sp = 0u;
    for (;;) {
        sum = 0u; cnt = 0u; mine = 0u;
#pragma unroll
        for (unsigned j = 0; j < 16; ++j) { const unsigned c = xb_ld(&bar[XB_XCNT(j)]); sum += c; cnt += (c > 0u) ? 1u : 0u; mine = (j == x) ? c : mine; }
        if (sum == G) break;
        __builtin_amdgcn_s_sleep(1);
        if ((++sp & 255u) == 0u) { if (xb_ld(&bar[XB_TMO])) break; if (sp > XB_SPIN_CAP) { atomicAdd(&bar[XB_TMO], 1u); break; } }
    }
    nloc = mine > 0u ? mine : 1u; nx = cnt > 0u ? cnt : 1u;
}

__device__ __forceinline__ void xcd_barrier(const XcdBarrier& b) {
    asm volatile("s_waitcnt vmcnt(0)" ::: "memory");
    __syncthreads();
    if (threadIdx.x == 0) {
        unsigned* bar = b.bar;
        __builtin_amdgcn_s_waitcnt(0);
        unsigned nloc = b.st[0], nx = b.st[1];
        if (nloc == 0u) { xcd_barrier_complete(bar, b.x, nloc, nx); b.st[0] = nloc; b.st[1] = nx; }
        const unsigned old = xb_add(&bar[XB_XSUB(b.x)], 1u);
        const unsigned gen = old / nloc;
        if (old + 1u == (gen + 1u) * nloc) {
            __builtin_amdgcn_fence(__ATOMIC_RELEASE, "agent");
            asm volatile("s_waitcnt vmcnt(0)" ::: "memory");
            const unsigned og = xb_add(&bar[XB_TOP], 1u);
            const unsigned tg = og / nx;
            if (og + 1u == (tg + 1u) * nx) xb_add(&bar[XB_TOPGEN], 1u);
            else XB_SPIN(xb_ld(&bar[XB_TOPGEN]) == tg, bar);
            __builtin_amdgcn_fence(__ATOMIC_ACQUIRE, "agent");
            xb_add(&bar[XB_XGEN(b.x)], 1u);
            asm volatile("s_waitcnt vmcnt(0)" ::: "memory");
        } else {
            XB_SPIN(xb_ld(&bar[XB_XGEN(b.x)]) == gen, bar);
            __builtin_amdgcn_fence(__ATOMIC_ACQUIRE, "agent");
            asm volatile("s_waitcnt vmcnt(0)" ::: "memory");
        }
    }
    __syncthreads();
}

constexpr int NWAVES = 8;
#ifndef LBW
#define LBW 2
#endif
constexpr int D = 1024, NP = 16384, NS = 2048, MT = NP + NS;
constexpr int PAST = 4096, NB = 32;
constexpr int WIN_LD = 4104;
constexpr float EPSN = 1e-6f;
constexpr float LOG2E = 1.4426950408889634f;
constexpr float C2 = 0.125f * LOG2E;
constexpr float NEGBIG = -1e30f;
constexpr size_t O_FKP = 18874368, O_FVP = 27262976, O_LFP = 35651584, O_DKP = 35782656, O_DVP = 44171264, O_FKS = 52559872, O_FVS = 53608448, O_LFS = 54657024, O_DKS = 54673408, O_DVS = 55721984, O_TOTAL = 56770560;
constexpr size_t MiB = 1u << 20;
constexpr size_t WS_CTL = 0, CTL_ZERO_BYTES = 65536;
constexpr size_t WS_WTIN = 2 * MiB, WS_WTOUT = 10 * MiB, WS_LCUM = 12 * MiB, WS_TTOT = 13 * MiB, WS_LC = 14 * MiB, WS_TC = 18 * MiB, WS_SS = 19 * MiB;
constexpr size_t WS_H = 32 * MiB;
constexpr size_t WS_SEG = 68 * MiB, SEG_BYTES = 18 * MiB;
constexpr size_t WS_STASH = 212 * MiB;
constexpr size_t WS_OUTF = 244 * MiB;
constexpr size_t WS_END = 316 * MiB;
constexpr int CW_BAR = 4096;
constexpr int CW_Q0 = 64, CW_Q1 = 128, CW_Q2 = 192, CW_Q3 = 256;
constexpr int RING_BYTES = 131072;
constexpr int MISC_OFF = RING_BYTES;
constexpr int LDS_BYTES = 147456;

typedef unsigned short bf16;
typedef unsigned v4u __attribute__((ext_vector_type(4)));
typedef float f32x4 __attribute__((ext_vector_type(4)));
typedef float f32x16 __attribute__((ext_vector_type(16)));
typedef short bf16x8 __attribute__((ext_vector_type(8)));
typedef short s16x4 __attribute__((ext_vector_type(4)));
typedef short v4i16_t __attribute__((ext_vector_type(4)));
#define LDS_WAIT() asm volatile("s_waitcnt lgkmcnt(0)" ::: "memory")

__device__ __forceinline__ unsigned f2bf(float f) { unsigned u = __builtin_bit_cast(unsigned, f); return (u + 0x7fffu + ((u >> 16) & 1u)) >> 16; }
__device__ __forceinline__ unsigned pk2(float lo, float hi) { return f2bf(lo) | (f2bf(hi) << 16); }
__device__ __forceinline__ float bf2f(unsigned short b) { return __builtin_bit_cast(float, (unsigned)b << 16); }
__device__ __forceinline__ float wave_sum(float v) {
#pragma unroll
    for (int o = 1; o < 64; o <<= 1) v += __shfl_xor(v, o);
    return v;
}
__device__ __forceinline__ int crow(int r, int hi) { return (r & 3) + 8 * (r >> 2) + 4 * hi; }

struct Args {
    const float* x_p; const float* x_s; const float* ck; const float* cv; const float* clf; const float* cdk; const float* cdv;
    const float* g_pre; const float* w_in; const float* b_f; const float* lq1; const float* lk1; const float* lq2; const float* lk2;
    const float* subln; const float* w_out; const float* g_post; const float* relb;
    float* out; unsigned char* ws;
};

__device__ __forceinline__ void p0_transpose_item(const float* W, int ldw, int K, int nblk, int split, int skip, bf16* WT, LAS float* scr, int item, int lane) {
    const int kb = item / nblk, nb = item % nblk, k0 = 64 * kb, n0 = 32 * nb, w0 = n0 + (n0 >= split ? skip : 0);
#pragma unroll 8
    for (int i = 0; i < 32; ++i) { const int kk = 2 * i + (lane >> 5); scr[kk * 33 + (lane & 31)] = W[(size_t)(k0 + kk) * ldw + w0 + (lane & 31)]; }
    LDS_WAIT(); asm volatile("" ::: "memory");
    const int c = lane & 7;
#pragma unroll
    for (int j = 0; j < 4; ++j) { const int n = (lane >> 3) + 8 * j; const LAS float* s = scr + (8 * c) * 33 + n;
        v4u o; o.x = pk2(s[0 * 33], s[1 * 33]); o.y = pk2(s[2 * 33], s[3 * 33]); o.z = pk2(s[4 * 33], s[5 * 33]); o.w = pk2(s[6 * 33], s[7 * 33]);
        *(v4u*)(WT + (size_t)(n0 + n) * K + k0 + 8 * c) = o; }
    LDS_WAIT(); asm volatile("" ::: "memory");
}

__device__ __forceinline__ void p0_prologue(const Args& A, LAS unsigned char* lds, int vcu, int G) {
    const int tid = threadIdx.x, lane = tid & 63, wave = __builtin_amdgcn_readfirstlane(tid >> 6);
    const int gw = vcu * NWAVES + wave, NGW = G * NWAVES;
    {
        LAS float* scr = (LAS float*)(lds + wave * 16384);
        bf16* WTin = (bf16*)(A.ws + WS_WTIN); bf16* WTout = (bf16*)(A.ws + WS_WTOUT);
        constexpr int I_IN = (D / 64) * (4096 / 32), I_OUT = (D / 64) * (D / 32);
        for (int it = gw; it < I_IN + I_OUT; it += NGW) {
            if (it < I_IN) p0_transpose_item(A.w_in, WIN_LD, D, 4096 / 32, 1536, 8, WTin, scr, it, lane);
            else p0_transpose_item(A.w_out, D, D, D / 32, 1 << 30, 0, WTout, scr, it - I_IN, lane);
        }
    }
    {
        float* LC = (float*)(A.ws + WS_LC); float* TC = (float*)(A.ws + WS_TC);
        for (int ch = gw; ch < NB * 64; ch += NGW) {
            const float* src = A.clf + (size_t)ch * 512 + lane * 8;
            f32x4 a = *(const f32x4*)src, b = *(const f32x4*)(src + 4);
            float v[8] = {a[0], a[1], a[2], a[3], b[0], b[1], b[2], b[3]};
#pragma unroll
            for (int o = 1; o < 64; o <<= 1) {
#pragma unroll
                for (int j = 0; j < 8; ++j) { const float t = __shfl_up(v[j], o); if (lane >= o) v[j] += t; }
            }
            float* dst = LC + (size_t)ch * 512 + lane * 8;
            *(f32x4*)dst = (f32x4){v[0], v[1], v[2], v[3]}; *(f32x4*)(dst + 4) = (f32x4){v[4], v[5], v[6], v[7]};
            if (lane == 63) { float* t = TC + (size_t)ch * 8; *(f32x4*)t = (f32x4){v[0], v[1], v[2], v[3]}; *(f32x4*)(t + 4) = (f32x4){v[4], v[5], v[6], v[7]}; }
        }
    }
    __syncthreads();
    {
        LAS float* wff = (LAS float*)lds;
        LAS float* lfb = (LAS float*)(lds + 32768);
        for (int i = tid; i < 1024 * 8; i += 512) wff[i] = A.w_in[(size_t)(i >> 3) * WIN_LD + 1536 + (i & 7)];
        __syncthreads();
        bf16* H = (bf16*)(A.ws + WS_H); float* LCUM = (float*)(A.ws + WS_LCUM); float* TTOT = (float*)(A.ws + WS_TTOT);
        f32x4 g[4];
#pragma unroll
        for (int j = 0; j < 4; ++j) g[j] = *(const f32x4*)(A.g_pre + 4 * lane + 256 * j);
        const float bfv = A.b_f[lane & 7];
        for (int blk = vcu; blk < MT / 64; blk += G) {
            for (int i = 0; i < 8; ++i) {
                const int rl = wave * 8 + i, row = blk * 64 + rl;
                const float* xr = (row < NP) ? (A.x_p + (size_t)row * D) : (A.x_s + (size_t)(row - NP) * D);
                f32x4 v[4]; float s = 0.f;
#pragma unroll
                for (int j = 0; j < 4; ++j) { v[j] = *(const f32x4*)(xr + 4 * lane + 256 * j); s += (v[j][0] * v[j][0] + v[j][1] * v[j][1]) + (v[j][2] * v[j][2] + v[j][3] * v[j][3]); }
                const float rstd = 1.0f / sqrtf(wave_sum(s) * (1.0f / D) + EPSN);
                float ff[8] = {0.f, 0.f, 0.f, 0.f, 0.f, 0.f, 0.f, 0.f};
                unsigned long long* o8 = (unsigned long long*)(H + (size_t)row * D) + lane;
#pragma unroll
                for (int j = 0; j < 4; ++j) {
                    const f32x4 hv = v[j] * rstd * g[j];
                    o8[64 * j] = (unsigned long long)pk2(hv[0], hv[1]) | ((unsigned long long)pk2(hv[2], hv[3]) << 32);
#pragma unroll
                    for (int e = 0; e < 4; ++e) { const LAS float* wr = wff + (size_t)(256 * j + 4 * lane + e) * 8; const f32x4 w0 = *(const LAS f32x4*)wr, w1 = *(const LAS f32x4*)(wr + 4);
                        ff[0] += hv[e] * w0[0]; ff[1] += hv[e] * w0[1]; ff[2] += hv[e] * w0[2]; ff[3] += hv[e] * w0[3];
                        ff[4] += hv[e] * w1[0]; ff[5] += hv[e] * w1[1]; ff[6] += hv[e] * w1[2]; ff[7] += hv[e] * w1[3]; }
                }
                float z = 0.f;
#pragma unroll
                for (int j = 0; j < 8; ++j) { const float t = wave_sum(ff[j]); z = ((lane & 7) == j) ? t : z; }
                z += bfv;
                const float lf = fminf(z, 0.f) - log1pf(expf(-fabsf(z)));
                if (lane < 8) { lfb[rl * 8 + lane] = lf;
                    if (row < NP) A.out[O_LFP + (size_t)row * 8 + lane] = lf; else A.out[O_LFS + (size_t)(row - NP) * 8 + lane] = lf; }
            }
            __syncthreads();
            if (tid < 8) { float run = 0.f;
                for (int r = 0; r < 64; ++r) { run += lfb[r * 8 + tid]; LCUM[(size_t)(blk * 64 + r) * 8 + tid] = run; }
                TTOT[blk * 8 + tid] = run; }
            __syncthreads();
        }
    }
}

constexpr int AL_K = 0, AL_V = 16384, AL_STG = 0, AL_CK = 65536, AL_WSF = 66048, AL_TOT = 68096, AL_DD = 69184, AL_TAB = 70272, AL_MISC = 73344;

__device__ __forceinline__ s16x4 vtr(const LAS unsigned char* p) { return __builtin_bit_cast(s16x4, __builtin_amdgcn_ds_read_tr16_b64_v4i16((LAS v4i16_t*)p)); }
__device__ __forceinline__ bf16x8 cvt8(const f32x4 a, const f32x4 b) {
    v4u w; w.x = pk2(a[0], a[1]); w.y = pk2(a[2], a[3]); w.z = pk2(b[0], b[1]); w.w = pk2(b[2], b[3]); return __builtin_bit_cast(bf16x8, w); }

struct AttnCtx {
    const bf16 *QF, *KF, *VF, *GF, *DQ, *DK, *DV, *GD; bf16* MIX;
    const float *LCUM, *TTOT, *LC, *TC;
    const float *ck, *cv, *cdk, *cdv;
    const float* subln; float lam; float* stash;
};

template <int KIND>
__device__ __forceinline__ void attn_unit(const AttnCtx& C, int u, LAS unsigned char* lds) {
    constexpr bool FOX = (KIND == 0 || KIND == 2), SAMPLE = (KIND >= 2);
    constexpr int DV = FOX ? 64 : 128, NDB = DV / 32, NMAP = FOX ? 1 : 2, NVC = DV / 64;
    int tid = threadIdx.x; asm volatile("" : "+v"(tid));
    const int lane = tid & 63, r32 = lane & 31, hi = lane >> 5; const int wid = __builtin_amdgcn_readfirstlane(tid >> 6);
    int h, qb = 0, b = 0, NT, qrow, qpos, tref;
    if (KIND == 0) { h = u & 7; qb = 63 - (u >> 3); }
    else if (KIND == 1) { h = u & 3; qb = 63 - (u >> 2); }
    else if (KIND == 2) { h = u & 7; b = u >> 3; }
    else { h = u & 3; b = u >> 2; }
    if (!SAMPLE) { NT = 4 * qb + 4; qrow = 256 * qb + 32 * wid + r32; qpos = qrow; tref = 4 * qb; }
    else { NT = 65; qrow = NP + b * 64 + 32 * (wid & 1) + r32; qpos = PAST + 32 * (wid & 1) + r32; tref = 64; }
    const bool compute_wave = SAMPLE ? (wid < 2) : true;
    LAS float* ckt = (LAS float*)(lds + AL_CK); LAS float* wsf = (LAS float*)(lds + AL_WSF) + wid * 64;
    LAS float* tot = (LAS float*)(lds + AL_TOT); LAS float* dd = (LAS float*)(lds + AL_DD); const LAS float* tab = (const LAS float*)(lds + AL_TAB) + h * 192;
    float cq = 0.f;
    if (FOX) {
        __syncthreads();
        for (int c = tid; c < NT; c += 512) { float t;
            if (!SAMPLE) t = C.TTOT[c * 8 + h]; else t = (c < 64) ? C.TC[(size_t)(b * 64 + c) * 8 + h] : C.TTOT[(256 + b) * 8 + h];
            tot[c] = t; }
        __syncthreads();
        for (int c = tid; c < NT; c += 512) { float s = 0.f;
            if (c < tref) { for (int k = c; k < tref; ++k) s -= tot[k]; } else { for (int k = tref; k < c; ++k) s += tot[k]; }
            dd[c] = s; }
        __syncthreads();
        const int qc = SAMPLE ? 64 : (qrow >> 6);
        cq = (dd[qc] + C.LCUM[(size_t)qrow * 8 + h]) * LOG2E;
    }
    const int kkey = (tid & 7) + 8 * (tid >> 6), kc = (tid >> 3) & 7; const int kdst = kc * 1024 + kkey * 16;
    for (int map = 0; map < NMAP; ++map) {
        bf16x8 qr[4];
        { const bf16* qsrc = FOX ? (C.QF + (size_t)qrow * 512 + h * 64) : (C.DQ + (size_t)qrow * 512 + h * 128 + map * 64);
#pragma unroll
          for (int d0 = 0; d0 < 4; ++d0) qr[d0] = *(const bf16x8*)(qsrc + d0 * 16 + hi * 8); }
        f32x16 o[NDB];
#pragma unroll
        for (int d = 0; d < NDB; ++d) o[d] = (f32x16){0.f,0.f,0.f,0.f,0.f,0.f,0.f,0.f,0.f,0.f,0.f,0.f,0.f,0.f,0.f,0.f};
        float m_run = NEGBIG, l_run = 0.f;
        v4u kraw[2]; v4u vraw[NVC][2]; float ckraw = 0.f;
        kraw[0] = (v4u){0,0,0,0}; kraw[1] = (v4u){0,0,0,0};
#pragma unroll
        for (int i = 0; i < NVC; ++i) { vraw[i][0] = (v4u){0,0,0,0}; vraw[i][1] = (v4u){0,0,0,0}; }
        auto stage_load = [&](int t) {
            const bool f32src = SAMPLE && (t < 64);
            if (f32src) {
                const float* kp;
                if (FOX) kp = C.ck + ((size_t)(b * PAST + t * 64 + kkey) * 8 + h) * 64 + kc * 8;
                else kp = C.cdk + ((size_t)(b * PAST + t * 64 + kkey) * 4 + h) * 128 + map * 64 + kc * 8;
                kraw[0] = *(const v4u*)kp; kraw[1] = *(const v4u*)(kp + 4);
#pragma unroll
                for (int i = 0; i < NVC; ++i) { const int idx = tid + 512 * i, vkey = idx / (DV / 8), vc = idx % (DV / 8);
                    const float* vp = FOX ? (C.cv + ((size_t)(b * PAST + t * 64 + vkey) * 8 + h) * 64 + vc * 8) : (C.cdv + ((size_t)(b * PAST + t * 64 + vkey) * 4 + h) * 128 + vc * 8);
                    vraw[i][0] = *(const v4u*)vp; vraw[i][1] = *(const v4u*)(vp + 4); }
            } else {
                const size_t krow = SAMPLE ? (size_t)(NP + b * 64 + kkey) : (size_t)(t * 64 + kkey);
                const bf16* kp = FOX ? (C.KF + krow * 512 + h * 64 + kc * 8) : (C.DK + krow * 512 + h * 128 + map * 64 + kc * 8);
                kraw[0] = *(const v4u*)kp;
#pragma unroll
                for (int i = 0; i < NVC; ++i) { const int idx = tid + 512 * i, vkey = idx / (DV / 8), vc = idx % (DV / 8);
                    const size_t vrow = SAMPLE ? (size_t)(NP + b * 64 + vkey) : (size_t)(t * 64 + vkey);
                    const bf16* vp = FOX ? (C.VF + vrow * 512 + h * 64 + vc * 8) : (C.DV + vrow * 512 + h * 128 + vc * 8);
                    vraw[i][0] = *(const v4u*)vp; }
            }
            if (FOX && tid < 64) {
                float lv;
                if (SAMPLE) lv = (t < 64) ? C.LC[(size_t)(b * PAST + t * 64 + tid) * 8 + h] : C.LCUM[(size_t)(NP + b * 64 + tid) * 8 + h];
                else lv = C.LCUM[(size_t)(t * 64 + tid) * 8 + h];
                ckraw = lv;
            }
        };
        auto stage_write = [&](int t, int buf) {
            const bool f32src = SAMPLE && (t < 64);
            LAS unsigned char* kb = lds + AL_K + buf * 8192; LAS unsigned char* vb = lds + AL_V + buf * 16384;
            if (f32src) *(LAS bf16x8*)(kb + kdst) = cvt8(__builtin_bit_cast(f32x4, kraw[0]), __builtin_bit_cast(f32x4, kraw[1])); else *(LAS v4u*)(kb + kdst) = kraw[0];
#pragma unroll
            for (int i = 0; i < NVC; ++i) { const int idx = tid + 512 * i, vkey = idx / (DV / 8), vc = idx % (DV / 8);
                const int vdst = (vc >> 2) * 4096 + (vkey >> 4) * 1024 + (vkey & 15) * 64 + (vc & 3) * 16;
                if (f32src) *(LAS bf16x8*)(vb + vdst) = cvt8(__builtin_bit_cast(f32x4, vraw[i][0]), __builtin_bit_cast(f32x4, vraw[i][1])); else *(LAS v4u*)(vb + vdst) = vraw[i][0]; }
            if (FOX && tid < 64) ckt[buf * 64 + tid] = (dd[t] + ckraw) * LOG2E;
        };
        __syncthreads();
        stage_load(0); stage_write(0, 0);
        __syncthreads();
        for (int t = 0; t < NT; ++t) {
            const int buf = t & 1;
            if (t + 1 < NT) stage_load(t + 1);
            if (compute_wave) {
                const LAS unsigned char* kt = lds + AL_K + buf * 8192; const LAS unsigned char* vt = lds + AL_V + buf * 16384;
                f32x16 p0, p1;
                if (FOX) {
#pragma unroll
                    for (int gq = 0; gq < 4; ++gq) { const f32x4 a = *(const LAS f32x4*)(ckt + buf * 64 + 8 * gq + 4 * hi), bq = *(const LAS f32x4*)(ckt + buf * 64 + 32 + 8 * gq + 4 * hi);
#pragma unroll
                        for (int e = 0; e < 4; ++e) { p0[4 * gq + e] = cq - a[e]; p1[4 * gq + e] = cq - bq[e]; } }
                } else {
                    const bool far_t = SAMPLE ? (t <= 61) : (t <= 4 * qb - 3);
                    const float c15 = far_t ? tab[0] : 0.f;
#pragma unroll
                    for (int r = 0; r < 16; ++r) { p0[r] = c15; p1[r] = c15; }
                }
                const LAS unsigned char* kbp = kt + hi * 1024 + r32 * 16;
#pragma unroll
                for (int d0 = 0; d0 < 4; ++d0) {
                    const bf16x8 b0 = *(const LAS bf16x8*)(kbp + d0 * 2048), b1 = *(const LAS bf16x8*)(kbp + d0 * 2048 + 512);
                    p0 = __builtin_amdgcn_mfma_f32_32x32x16_bf16(b0, qr[d0], p0, 0, 0, 0);
                    p1 = __builtin_amdgcn_mfma_f32_32x32x16_bf16(b1, qr[d0], p1, 0, 0, 0);
                }
                if (!FOX) {
                    const bool far_t = SAMPLE ? (t <= 61) : (t <= 4 * qb - 3);
#ifndef T_NONEAR
                    if (!far_t) {
#pragma unroll
                        for (int r = 0; r < 16; ++r) { const int rel0 = t * 64 + crow(r, hi) - qpos; int i0 = rel0 < -128 ? -128 : rel0; i0 = i0 > 63 ? 63 : i0; int i1 = rel0 + 32 < -128 ? -128 : rel0 + 32; i1 = i1 > 63 ? 63 : i1;
                            p0[r] += tab[i0 + 128]; p1[r] += tab[i1 + 128]; }
                    }
#endif
                    if (!SAMPLE) { if (t > (qpos >> 6)) {
#pragma unroll
                        for (int r = 0; r < 16; ++r) { p0[r] = NEGBIG; p1[r] = NEGBIG; } } }
                } else {
                    const bool band = SAMPLE ? (t == 64) : (t >= 4 * qb);
                    if (band) { const int kb0 = (SAMPLE ? PAST : t * 64);
#pragma unroll
                        for (int r = 0; r < 16; ++r) { const int kv = kb0 + crow(r, hi); if (kv > qpos) p0[r] = NEGBIG; if (kv + 32 > qpos) p1[r] = NEGBIG; } }
                }
                float rm = fmaxf(p0[0], p1[0]);
#pragma unroll
                for (int r = 1; r < 16; ++r) rm = fmaxf(rm, fmaxf(p0[r], p1[r]));
                rm = fmaxf(rm, __shfl_xor(rm, 32));
                const float m_new = fmaxf(m_run, rm); const float alpha = __builtin_amdgcn_exp2f(m_run - m_new); m_run = m_new;
                float rs = 0.f;
#pragma unroll
                for (int r = 0; r < 16; ++r) { p0[r] = __builtin_amdgcn_exp2f(p0[r] - m_new); p1[r] = __builtin_amdgcn_exp2f(p1[r] - m_new); rs += p0[r] + p1[r]; }
                l_run = l_run * alpha + rs;
                if (hi == 0) wsf[r32] = alpha;
#pragma unroll
                for (int gq = 0; gq < 4; ++gq) { const f32x4 a = *(const LAS f32x4*)(wsf + 8 * gq + 4 * hi);
#pragma unroll
                    for (int d = 0; d < NDB; ++d)
#pragma unroll
                        for (int e = 0; e < 4; ++e) o[d][4 * gq + e] *= a[e]; }
                v4u pw[4];
                pw[0] = (v4u){pk2(p0[0], p0[1]), pk2(p0[2], p0[3]), pk2(p0[4], p0[5]), pk2(p0[6], p0[7])};
                pw[1] = (v4u){pk2(p0[8], p0[9]), pk2(p0[10], p0[11]), pk2(p0[12], p0[13]), pk2(p0[14], p0[15])};
                pw[2] = (v4u){pk2(p1[0], p1[1]), pk2(p1[2], p1[3]), pk2(p1[4], p1[5]), pk2(p1[6], p1[7])};
                pw[3] = (v4u){pk2(p1[8], p1[9]), pk2(p1[10], p1[11]), pk2(p1[12], p1[13]), pk2(p1[14], p1[15])};
                const LAS unsigned char* vp = vt + ((lane >> 4) & 1) * 32 + (lane & 3) * 8 + (4 * hi + ((lane & 15) >> 2)) * 64;
#pragma unroll
                for (int d = 0; d < NDB; ++d)
#pragma unroll
                    for (int ks = 0; ks < 4; ++ks) {
                        const s16x4 lo = vtr(vp + d * 4096 + ks * 1024), hh = vtr(vp + d * 4096 + ks * 1024 + 512);
                        const bf16x8 vf = (bf16x8){lo[0], lo[1], lo[2], lo[3], hh[0], hh[1], hh[2], hh[3]};
                        o[d] = __builtin_amdgcn_mfma_f32_32x32x16_bf16(__builtin_bit_cast(bf16x8, pw[ks]), vf, o[d], 0, 0, 0);
                        if (ks == 3) __builtin_amdgcn_sched_barrier(0);
                    }
            }
            if (t + 1 < NT) stage_write(t + 1, buf ^ 1);
            __syncthreads();
        }
        if (compute_wave) {
            int tidf = threadIdx.x; asm volatile("" : "+v"(tidf));
            const int lanef = tidf & 63;
            float lt = l_run + __shfl_xor(l_run, 32);
            const float inv = 1.0f / lt;
            if (hi == 0) wsf[r32] = inv;
            float rinv[16];
#pragma unroll
            for (int gq = 0; gq < 4; ++gq) { const f32x4 a = *(const LAS f32x4*)(wsf + 8 * gq + 4 * hi); rinv[4 * gq] = a[0]; rinv[4 * gq + 1] = a[1]; rinv[4 * gq + 2] = a[2]; rinv[4 * gq + 3] = a[3]; }
            const int rowb = SAMPLE ? (NP + b * 64 + 32 * (wid & 1)) : (256 * qb + 32 * wid);
            if (!FOX && map == 0) {
                f32x4* st = (f32x4*)(C.stash + ((size_t)blockIdx.x * 512 + tidf) * (NDB * 16));
#pragma unroll
                for (int d = 0; d < NDB; ++d)
#pragma unroll
                    for (int gq = 0; gq < 4; ++gq) st[d * 4 + gq] = (f32x4){o[d][4 * gq] * rinv[4 * gq], o[d][4 * gq + 1] * rinv[4 * gq + 1], o[d][4 * gq + 2] * rinv[4 * gq + 2], o[d][4 * gq + 3] * rinv[4 * gq + 3]};
            } else {
                LAS bf16* stg = (LAS bf16*)(lds + AL_STG) + wid * (32 * DV);
                if (FOX) {
#pragma unroll
                    for (int d = 0; d < NDB; ++d)
#pragma unroll
                        for (int r = 0; r < 16; ++r) stg[crow(r, hi) * DV + 32 * d + r32] = (bf16)f2bf(o[d][r] * rinv[r]);
                } else {
                    const f32x4* st = (const f32x4*)(C.stash + ((size_t)blockIdx.x * 512 + tidf) * (NDB * 16));
#pragma unroll
                    for (int d = 0; d < NDB; ++d)
#pragma unroll
                        for (int gq = 0; gq < 4; ++gq) { const f32x4 s1 = st[d * 4 + gq];
#pragma unroll
                            for (int e = 0; e < 4; ++e) { const int r = 4 * gq + e; stg[crow(r, hi) * DV + 32 * d + r32] = (bf16)f2bf(s1[e] - C.lam * (o[d][r] * rinv[r])); } }
                }
                LDS_WAIT(); asm volatile("" ::: "memory");
                constexpr int LPR = DV / 8;
                constexpr int RPP = 64 / LPR;
                const int cl = lanef % LPR;
#pragma unroll
                for (int ps = 0; ps < 32 / RPP; ++ps) {
                    const int rl = ps * RPP + lanef / LPR; const size_t row = (size_t)(rowb + rl);
                    const v4u sv = *(const LAS v4u*)(stg + rl * DV + cl * 8);
                    float xv[8];
                    xv[0] = __builtin_bit_cast(float, sv.x << 16); xv[1] = __builtin_bit_cast(float, sv.x & 0xffff0000u); xv[2] = __builtin_bit_cast(float, sv.y << 16); xv[3] = __builtin_bit_cast(float, sv.y & 0xffff0000u);
                    xv[4] = __builtin_bit_cast(float, sv.z << 16); xv[5] = __builtin_bit_cast(float, sv.z & 0xffff0000u); xv[6] = __builtin_bit_cast(float, sv.w << 16); xv[7] = __builtin_bit_cast(float, sv.w & 0xffff0000u);
                    const bf16* gp = FOX ? (C.GF + row * 512 + h * 64 + cl * 8) : (C.GD + row * 512 + h * 128 + cl * 8);
                    const v4u gv = *(const v4u*)gp;
                    float gg[8];
                    gg[0] = __builtin_bit_cast(float, gv.x << 16); gg[1] = __builtin_bit_cast(float, gv.x & 0xffff0000u); gg[2] = __builtin_bit_cast(float, gv.y << 16); gg[3] = __builtin_bit_cast(float, gv.y & 0xffff0000u);
                    gg[4] = __builtin_bit_cast(float, gv.z << 16); gg[5] = __builtin_bit_cast(float, gv.z & 0xffff0000u); gg[6] = __builtin_bit_cast(float, gv.w << 16); gg[7] = __builtin_bit_cast(float, gv.w & 0xffff0000u);
                    if (!FOX) {
                        float sq = 0.f;
#pragma unroll
                        for (int e = 0; e < 8; ++e) sq += xv[e] * xv[e];
#pragma unroll
                        for (int s = 1; s < LPR; s <<= 1) sq += __shfl_xor(sq, s);
                        const float rs = (1.0f / sqrtf(sq * (1.0f / 128.0f) + EPSN)) * 0.8f;
                        const f32x4 s0 = *(const f32x4*)(C.subln + cl * 8), s1 = *(const f32x4*)(C.subln + cl * 8 + 4);
#pragma unroll
                        for (int e = 0; e < 4; ++e) { xv[e] *= rs * s0[e]; xv[4 + e] *= rs * s1[e]; }
                    }
                    v4u ov; ov.x = pk2(xv[0] * gg[0], xv[1] * gg[1]); ov.y = pk2(xv[2] * gg[2], xv[3] * gg[3]); ov.z = pk2(xv[4] * gg[4], xv[5] * gg[5]); ov.w = pk2(xv[6] * gg[6], xv[7] * gg[7]);
                    bf16* op = FOX ? (C.MIX + row * 1024 + h * 64 + cl * 8) : (C.MIX + row * 1024 + 512 + h * 128 + cl * 8);
                    *(v4u*)op = ov;
                }
            }
        }
    }
}

template <int KIND>
__device__ __forceinline__ void attn_queue(const AttnCtx& C, unsigned* head, int nunits, LAS unsigned char* lds) {
    volatile LAS unsigned* slot = (volatile LAS unsigned*)(lds + AL_MISC);
    for (;;) {
        __syncthreads();
        if (threadIdx.x == 0) slot[0] = __hip_atomic_fetch_add(head, 1u, __ATOMIC_RELAXED, __HIP_MEMORY_SCOPE_AGENT);
        __syncthreads();
        const unsigned u = slot[0];
        if (u >= (unsigned)nunits) break;
        attn_unit<KIND>(C, (int)u, lds);
    }
}

__device__ __forceinline__ int t5_bucket(int rel) {
    const int n = rel < 0 ? -rel : rel; int bk;
    if (n < 8) bk = n; else bk = n < 12 ? 8 : n < 16 ? 9 : n < 23 ? 10 : n < 32 ? 11 : n < 46 ? 12 : n < 64 ? 13 : n < 91 ? 14 : 15;
    return bk + (rel > 0 ? 16 : 0);
}

__global__ void __launch_bounds__(NWAVES * 64, LBW) fwd_kernel(Args A) {
    extern __shared__ __attribute__((aligned(16))) unsigned char lds_raw[];
    LAS unsigned char* lds = (LAS unsigned char*)lds_raw;
    const int tid = threadIdx.x, lane = tid & 63; const int wave = __builtin_amdgcn_readfirstlane(tid >> 6);
    const int G = gridDim.x; const int bx = blockIdx.x; const int vcu = (G % 8 == 0) ? (bx % 8) * (G / 8) + bx / 8 : bx;
    volatile LAS unsigned* MISC = (volatile LAS unsigned*)(lds + MISC_OFF);
    for (int i = tid; i < (LDS_BYTES - MISC_OFF) / 4; i += NWAVES * 64) MISC[i] = 0u;
    __syncthreads();
    unsigned* ctl = (unsigned*)(A.ws + WS_CTL);
    XcdBarrier bar = xcd_barrier_post(ctl + CW_BAR, MISC + 8);

    p0_prologue(A, lds, vcu, G);
    xcd_barrier(bar);

    {
        pg8::Gemm g{(const pg8::bf16_t*)(A.ws + WS_H), (const pg8::bf16_t*)(A.ws + WS_WTIN), MT, 4096, D};
        pg8::StaticOrder S; S.init(MT, 4096, G, bx);
        pg8::EpiIn E{(pg8::bf16_t*)(A.ws + WS_SEG), SEG_BYTES / 2, A.out, C2};
        pg8::gemm_phase<pg8::EpiIn, pg8::StaticOrder, true, true>(lds, g, S, E);
    }
    xcd_barrier(bar);

    {
        AttnCtx C;
        C.QF = (const bf16*)(A.ws + WS_SEG); C.KF = C.QF + SEG_BYTES / 2; C.VF = C.KF + SEG_BYTES / 2; C.GF = C.VF + SEG_BYTES / 2;
        C.DQ = C.GF + SEG_BYTES / 2; C.DK = C.DQ + SEG_BYTES / 2; C.DV = C.DK + SEG_BYTES / 2; C.GD = C.DV + SEG_BYTES / 2;
        C.MIX = (bf16*)(A.ws + WS_H);
        C.LCUM = (const float*)(A.ws + WS_LCUM); C.TTOT = (const float*)(A.ws + WS_TTOT); C.LC = (const float*)(A.ws + WS_LC); C.TC = (const float*)(A.ws + WS_TC);
        C.ck = A.ck; C.cv = A.cv; C.cdk = A.cdk; C.cdv = A.cdv; C.subln = A.subln; C.stash = (float*)(A.ws + WS_STASH);
        LAS float* tabw = (LAS float*)(lds + AL_TAB); LAS float* misc = (LAS float*)(lds + AL_MISC);
        if (wave == 0) {
            const float a = wave_sum(A.lq1[lane] * A.lk1[lane]), c = wave_sum(A.lq2[lane] * A.lk2[lane]);
            if (lane == 0) misc[4] = expf(a) - expf(c) + 0.2f;
        }
        for (int i = tid; i < 4 * 192; i += 512) { const int hh = i / 192, rel = (i % 192) - 128; tabw[i] = A.relb[t5_bucket(rel) * 4 + hh] * LOG2E; }
        __syncthreads();
        C.lam = misc[4];
#ifndef NO_K1
        attn_queue<1>(C, ctl + CW_Q0, 256, lds);
#endif
#ifndef NO_K3
        attn_queue<3>(C, ctl + CW_Q1, 128, lds);
#endif
#ifndef NO_K2
        attn_queue<2>(C, ctl + CW_Q2, 256, lds);
#endif
#ifndef NO_K0
        attn_queue<0>(C, ctl + CW_Q3, 512, lds);
#endif
    }
    xcd_barrier(bar);

    {
        pg8::Gemm g{(const pg8::bf16_t*)(A.ws + WS_H), (const pg8::bf16_t*)(A.ws + WS_WTOUT), MT, D, D};
        pg8::StaticOrder S; S.init(MT, D, G, bx);
        pg8::EpiOut E{(float*)(A.ws + WS_OUTF), (float*)(A.ws + WS_SS)};
        pg8::gemm_phase<pg8::EpiOut, pg8::StaticOrder, true, true>(lds, g, S, E);
    }
    xcd_barrier(bar);

    {
        const float* OUTF = (const float*)(A.ws + WS_OUTF); const float* SS = (const float*)(A.ws + WS_SS);
        const int gw = vcu * NWAVES + wave, NGW = G * NWAVES;
        f32x4 g[4];
#pragma unroll
        for (int j = 0; j < 4; ++j) g[j] = *(const f32x4*)(A.g_post + 4 * lane + 256 * j);
        for (int row = gw; row < MT; row += NGW) {
            const float sv = (lane < 16) ? SS[(size_t)row * 16 + lane] : 0.f;
            const float rstd = 1.0f / sqrtf(wave_sum(sv) * (1.0f / D) + EPSN);
            const float* xr = (row < NP) ? (A.x_p + (size_t)row * D) : (A.x_s + (size_t)(row - NP) * D);
            const float* orow = OUTF + (size_t)row * D; float* yr = A.out + (size_t)row * D;
#pragma unroll
            for (int j = 0; j < 4; ++j) { const f32x4 xv = *(const f32x4*)(xr + 4 * lane + 256 * j), ov = *(const f32x4*)(orow + 4 * lane + 256 * j);
                *(f32x4*)(yr + 4 * lane + 256 * j) = xv + ov * rstd * g[j]; }
        }
    }
}

extern "C" void kernel_launch(void* const* d_in, const int* in_sizes, int n_in, void* d_out, int out_size, void* d_ws, size_t ws_size, hipStream_t stream) {
    static int grid = 0;
    if (grid == 0) {
        if (n_in != 18 || in_sizes[0] != NP * D || (size_t)out_size != O_TOTAL || ws_size < WS_END) {
            fprintf(stderr, "kernel_launch: unexpected shapes: n_in %d in0 %d out %d ws %zu; nothing launched\n", n_in, n_in > 0 ? in_sizes[0] : -1, out_size, ws_size); grid = -1; return; }
        int dev = 0, cus = 0, per_cu = 0;
        if (hipGetDevice(&dev) != hipSuccess || hipDeviceGetAttribute(&cus, hipDeviceAttributeMultiprocessorCount, dev) != hipSuccess) { grid = -1; return; }
        if (hipFuncSetAttribute((const void*)fwd_kernel, hipFuncAttributeMaxDynamicSharedMemorySize, LDS_BYTES) != hipSuccess) { fprintf(stderr, "kernel_launch: hipFuncSetAttribute failed\n"); grid = -1; return; }
        if (hipOccupancyMaxActiveBlocksPerMultiprocessor(&per_cu, (const void*)fwd_kernel, NWAVES * 64, LDS_BYTES) != hipSuccess || per_cu < 1) {
            fprintf(stderr, "kernel_launch: occupancy query says %d blocks per CU; nothing launched\n", per_cu); (void)hipGetLastError(); grid = -1; return; }
        grid = cus;
    }
    if (grid < 0) return;
    (void)hipMemsetAsync((char*)d_ws + WS_CTL, 0, CTL_ZERO_BYTES, stream);
    Args a{};
    a.x_p = (const float*)d_in[0]; a.x_s = (const float*)d_in[1]; a.ck = (const float*)d_in[2]; a.cv = (const float*)d_in[3]; a.clf = (const float*)d_in[4];
    a.cdk = (const float*)d_in[5]; a.cdv = (const float*)d_in[6]; a.g_pre = (const float*)d_in[7]; a.w_in = (const float*)d_in[8]; a.b_f = (const float*)d_in[9];
    a.lq1 = (const float*)d_in[10]; a.lk1 = (const float*)d_in[11]; a.lq2 = (const float*)d_in[12]; a.lk2 = (const float*)d_in[13]; a.subln = (const float*)d_in[14];
    a.w_out = (const float*)d_in[15]; a.g_post = (const float*)d_in[16]; a.relb = (const float*)d_in[17];
    a.out = (float*)d_out; a.ws = (unsigned char*)d_ws;
    hipLaunchKernelGGL(fwd_kernel, dim3(grid), dim3(NWAVES * 64), LDS_BYTES, stream, a);
    const hipError_t le = hipPeekAtLastError();
    if (le != hipSuccess) fprintf(stderr, "kernel_launch: launch failed: %s\n", hipGetErrorName(le));
}
```

```cpp
#include <hip/hip_runtime.h>
#include <cstdio>
#include <cstdint>
#define GAS __attribute__((address_space(1)))
#define LAS __attribute__((address_space(3)))
namespace pg8 {
#define PG8_LAS __attribute__((address_space(3)))
typedef unsigned short bf16_t;
typedef short bf16x8 __attribute__((ext_vector_type(8)));
typedef float f32x4 __attribute__((ext_vector_type(4)));
typedef unsigned u32x4 __attribute__((ext_vector_type(4)));
constexpr int BM = 256, BK = 64, HALF = 128, HTB = HALF * BK * 2  , STAGE_BYTES = 8 * HTB, NXCD = 8, WGM = 8;

__host__ __device__ __forceinline__ int lds_byte(int r, int c) { const int st = (r >> 4) * 2 + (c >> 5), rr = r & 15, cc = c & 31, ob = rr * 64 + cc * 2; return st * 1024 + (ob ^ (((ob >> 9) & 1) << 5)); }
__host__ __device__ __forceinline__ void stage_rc(int b, int& R, int& C) { const int st = b / 1024, sb = b % 1024, swz = sb ^ (((sb >> 9) & 1) << 5); R = (st >> 1) * 16 + swz / 64; C = (st & 1) * 32 + (swz % 64) / 2; }
__host__ __device__ __forceinline__ int perm32(int rho) { const int n = rho >> 4, i = rho & 15; return 8 * (i >> 2) + 4 * n + (i & 3); }

struct Unit { int pm, pn; };
struct Gemm { const bf16_t* A; const bf16_t* Bt; int M, N, K; };

struct StaticOrder {
    int nM, nN, nwg, G, c;
    __host__ __device__ void init(int M, int N, int G_, int c_) { nM = M / BM; nN = N / BM; nwg = nM * nN; G = G_; c = c_; }
    __host__ __device__ bool next(int i, Unit& u) const {
        const long L = (long)i * G + c; if (L >= nwg) return false;
        int wgid = (int)L; { const int q = nwg / NXCD, r = nwg % NXCD, xcd = wgid % NXCD, off = wgid / NXCD; wgid = (xcd < r ? xcd * (q + 1) : r * (q + 1) + (xcd - r) * q) + off; }
        const int nig = WGM * nN, gid = wgid / nig, fm = gid * WGM, gsz = (nM - fm) < WGM ? (nM - fm) : WGM;
        u.pm = fm + ((wgid % nig) % gsz); u.pn = (wgid % nig) / gsz; return true;
    }
    __device__ __forceinline__ void a_ready(const Unit&) const {}
    __device__ __forceinline__ void done(const Unit&) const {}
};

__device__ __forceinline__ unsigned cvt_pk_bf16(float lo, float hi) { unsigned r; asm volatile("v_cvt_pk_bf16_f32 %0, %1, %2" : "=v"(r) : "v"(lo), "v"(hi)); return r; }
typedef float f32x2 __attribute__((ext_vector_type(2)));
typedef float f32x2 __attribute__((ext_vector_type(2)));
__device__ __forceinline__ float silu_f(float x) { return x * __builtin_amdgcn_rcpf(1.0f + __builtin_amdgcn_exp2f(-1.4426950408889634f * x)); }
struct EpiIn {
    static constexpr bool PERM = true, AFTER_DRAIN = false;
    bf16_t* segbase; size_t segstride;
    float* out;
    float c2; unsigned* nrm;
    __device__ __forceinline__ void norm_max(const f32x4 (&acc)[2][2][4][2], const Unit& u, int wc, float sc, int base) const {
        float mx[2] = {0.f, 0.f};
#pragma unroll
        for (int ai = 0; ai < 2; ++ai)
#pragma unroll
            for (int m = 0; m < 4; ++m)
#pragma unroll
                for (int bj = 0; bj < 2; ++bj) { const f32x4 a = acc[ai][bj][m][0] * sc, b = acc[ai][bj][m][1] * sc;
                    float s = (a[0] * a[0] + a[1] * a[1]) + (a[2] * a[2] + a[3] * a[3]) + (b[0] * b[0] + b[1] * b[1]) + (b[2] * b[2] + b[3] * b[3]);
                    s += __shfl_xor(s, 16); s += __shfl_xor(s, 32); mx[bj] = fmaxf(mx[bj], s); }
#pragma unroll
        for (int bj = 0; bj < 2; ++bj) {
#pragma unroll
            for (int o = 1; o < 16; o <<= 1) mx[bj] = fmaxf(mx[bj], __shfl_xor(mx[bj], o));
            if ((threadIdx.x & 63) == 0) { const int head = (u.pn & 1) * 4 + bj * 2 + (wc >> 1); atomicMax(nrm + base + head * 2 + (wc & 1), __float_as_uint(mx[bj])); } }
    }
    __device__ __forceinline__ void operator()(const f32x4 (&acc)[2][2][4][2], const Unit& u, int wr, int wc, int fr, int fq) const {
        const int seg = u.pn >> 1;
        const int col0 = (u.pn & 1) * 256 + wc * 32 + 8 * fq;
        const int row0 = u.pm * BM + wr * 64 + fr;
        bf16_t* bb = segbase + (size_t)seg * segstride;
        const bool is_s = (u.pm >= 64);
        const int mode = (seg == 0 || seg == 4) ? 0 : ((seg == 3 || seg == 7) ? 2 : 1);
        if (seg == 0) norm_max(acc, u, wc, c2, 0);
        if (seg == 1) norm_max(acc, u, wc, 1.0f, 16);
        if (mode == 1) {
            const size_t offp = seg == 1 ? (size_t)18874368 : seg == 2 ? (size_t)27262976 : seg == 5 ? (size_t)35782656 : (size_t)44171264;
            const size_t offs = seg == 1 ? (size_t)52559872 : seg == 2 ? (size_t)53608448 : seg == 5 ? (size_t)54673408 : (size_t)55721984;
            float* fb = out + (is_s ? offs : offp);
            const int rsub = is_s ? 16384 : 0;
#pragma unroll
            for (int ai = 0; ai < 2; ++ai)
#pragma unroll
                for (int m = 0; m < 4; ++m) { const int row = row0 + ai * HALF + m * 16;
                    bf16_t* rowp = bb + (size_t)row * 512 + col0; float* frow = fb + (size_t)(row - rsub) * 512 + col0;
#pragma unroll
                    for (int bj = 0; bj < 2; ++bj) { const f32x4 v0 = acc[ai][bj][m][0], v1 = acc[ai][bj][m][1];
                        *(f32x4*)(frow + bj * HALF) = v0; *(f32x4*)(frow + bj * HALF + 4) = v1;
                        u32x4 w; w.x = cvt_pk_bf16(v0[0], v0[1]); w.y = cvt_pk_bf16(v0[2], v0[3]); w.z = cvt_pk_bf16(v1[0], v1[1]); w.w = cvt_pk_bf16(v1[2], v1[3]);
                        *(u32x4*)(rowp + bj * HALF) = w; } }
        } else if (mode == 0) {
            const float sc = c2;
#pragma unroll
            for (int ai = 0; ai < 2; ++ai)
#pragma unroll
                for (int m = 0; m < 4; ++m) { const int row = row0 + ai * HALF + m * 16; bf16_t* rowp = bb + (size_t)row * 512 + col0;
#pragma unroll
                    for (int bj = 0; bj < 2; ++bj) { const f32x4 v0 = acc[ai][bj][m][0] * sc, v1 = acc[ai][bj][m][1] * sc;
                        u32x4 w; w.x = cvt_pk_bf16(v0[0], v0[1]); w.y = cvt_pk_bf16(v0[2], v0[3]); w.z = cvt_pk_bf16(v1[0], v1[1]); w.w = cvt_pk_bf16(v1[2], v1[3]);
                        *(u32x4*)(rowp + bj * HALF) = w; } }
        } else {
#pragma unroll
            for (int ai = 0; ai < 2; ++ai)
#pragma unroll
                for (int m = 0; m < 4; ++m) { const int row = row0 + ai * HALF + m * 16; bf16_t* rowp = bb + (size_t)row * 512 + col0;
#pragma unroll
                    for (int bj = 0; bj < 2; ++bj) { const f32x4 a0 = acc[ai][bj][m][0], a1 = acc[ai][bj][m][1];
                        u32x4 w; w.x = cvt_pk_bf16(silu_f(a0[0]), silu_f(a0[1])); w.y = cvt_pk_bf16(silu_f(a0[2]), silu_f(a0[3]));
                        w.z = cvt_pk_bf16(silu_f(a1[0]), silu_f(a1[1])); w.w = cvt_pk_bf16(silu_f(a1[2]), silu_f(a1[3]));
                        *(u32x4*)(rowp + bj * HALF) = w; } }
        }
    }
};
struct EpiOut {
    static constexpr bool PERM = false, AFTER_DRAIN = false;
    float* outf; float* ss;
    __device__ __forceinline__ void operator()(const f32x4 (&acc)[2][2][4][2], const Unit& u, int wr, int wc, int fr, int fq) const {
        const int col0 = u.pn * BM + wc * 32 + 4 * fq;
#pragma unroll
        for (int ai = 0; ai < 2; ++ai)
#pragma unroll
            for (int m = 0; m < 4; ++m) { const int row = u.pm * BM + ai * HALF + wr * 64 + m * 16 + fr; float* rp = outf + (size_t)row * 1024 + col0; float s = 0.f;
#pragma unroll
                for (int bj = 0; bj < 2; ++bj)
#pragma unroll
                    for (int n = 0; n < 2; ++n) { const f32x4 v = acc[ai][bj][m][n]; *(f32x4*)(rp + bj * HALF + n * 16) = v; s += (v[0] * v[0] + v[1] * v[1]) + (v[2] * v[2] + v[3] * v[3]); }
                s += __shfl_xor(s, 16); s += __shfl_xor(s, 32);
                if (fq == 0) ss[(size_t)row * 16 + u.pn * 4 + wc] = s; }
    }
};
template <class Epi, class Sched, bool ALIGN_EPI = false, bool SP2 = false>
__device__ __forceinline__ void gemm_phase(PG8_LAS unsigned char* lds, const Gemm g, const Sched& S, const Epi& E) {
    const int tid = threadIdx.x, wid = __builtin_amdgcn_readfirstlane(tid >> 6), lane = tid & 63, wr = wid >> 2, wc = wid & 3, fr = lane & 15, fq = lane >> 4;
    const int K = g.K, nt = K / BK;
    unsigned voffA[2], voffB[2];
#pragma unroll
    for (int i = 0; i < 2; ++i) { int R, C; stage_rc(tid * 16 + i * 8192, R, C); const int Rb = Epi::PERM ? ((R & ~31) + perm32(R & 31)) : R;
        voffA[i] = (unsigned)(R * K + C) * 2u; voffB[i] = (unsigned)(Rb * K + C) * 2u; }
    const size_t kstep = (size_t)(BK * 2);
    const size_t hstep = (size_t)HALF * K * 2;
    const size_t tstep = 2 * hstep;
    const unsigned ldsw = (unsigned)wid * 1024u;
    const int aoff = lds_byte(wr * 64 + fr, fq * 8), boff = lds_byte(wc * 32 + fr, fq * 8);
#define PG8_SA(b, h) (((b) * 2 + (h)) * HTB)
#define PG8_SB(b, h) ((4 + (b) * 2 + (h)) * HTB)
#define PG8_STAGE(bufoff, gbase, voff) do { _Pragma("unroll") for (int _i = 0; _i < 2; ++_i) \
        __builtin_amdgcn_global_load_lds((const unsigned*)((const char*)(gbase) + (voff)[_i]), (PG8_LAS unsigned*)(lds + (bufoff) + ldsw + _i * 8192), 16, 0, 0); } while (0)
#define PG8_LDA(dst, b, h) do { _Pragma("unroll") for (int m = 0; m < 4; ++m) _Pragma("unroll") for (int k = 0; k < 2; ++k) dst[m][k] = *(const PG8_LAS bf16x8*)(lds + PG8_SA(b, h) + aoff + m * 2048 + k * 1024); } while (0)
#define PG8_LDB(dst, b, h) do { _Pragma("unroll") for (int n = 0; n < 2; ++n) _Pragma("unroll") for (int k = 0; k < 2; ++k) dst[n][k] = *(const PG8_LAS bf16x8*)(lds + PG8_SB(b, h) + boff + n * 2048 + k * 1024); } while (0)
#define PG8_MMA(ai, bj, At, Bt) do { __builtin_amdgcn_s_setprio(1); _Pragma("unroll") for (int m = 0; m < 4; ++m) _Pragma("unroll") for (int n = 0; n < 2; ++n) _Pragma("unroll") for (int k = 0; k < 2; ++k) \
        acc[ai][bj][m][n] = __builtin_amdgcn_mfma_f32_16x16x32_bf16(Bt[n][k], At[m][k], acc[ai][bj][m][n], 0, 0, 0); __builtin_amdgcn_s_setprio(0); } while (0)
#define PG8_WAIT_V(n) asm volatile("s_waitcnt vmcnt(" #n ")" ::: "memory")
#define PG8_WAIT_L(n) asm volatile("s_waitcnt lgkmcnt(" #n ")" ::: "memory")
#define PG8_BAR __builtin_amdgcn_s_barrier()
#define PG8_SCHED __builtin_amdgcn_sched_barrier(0)
    Unit cur, nxt; int ui = 0;
    if (!S.next(0, cur)) return;
    f32x4 acc[2][2][4][2];
#pragma unroll
    for (int a = 0; a < 2; ++a)
#pragma unroll
        for (int b = 0; b < 2; ++b)
#pragma unroll
            for (int m = 0; m < 4; ++m)
#pragma unroll
                for (int n = 0; n < 2; ++n) acc[a][b][m][n] = (f32x4){0.f, 0.f, 0.f, 0.f};
    bf16x8 At[4][2], B0[2][2], B1[2][2];
    const char* cA = (const char*)g.A + (size_t)cur.pm * tstep; const char* cB = (const char*)g.Bt + (size_t)cur.pn * tstep;
    S.a_ready(cur);
    if constexpr (SP2) {
        PG8_STAGE(PG8_SB(0, 0), cB, voffB); PG8_STAGE(PG8_SB(0, 1), cB + hstep, voffB); PG8_STAGE(PG8_SA(0, 0), cA, voffA); PG8_STAGE(PG8_SA(0, 1), cA + hstep, voffA);
        if (wr == 1) PG8_BAR;
        PG8_WAIT_V(2); PG8_BAR;
        PG8_STAGE(PG8_SB(1, 0), cB + kstep, voffB); PG8_STAGE(PG8_SA(1, 0), cA + kstep, voffA); PG8_STAGE(PG8_SB(1, 1), cB + hstep + kstep, voffB);
        PG8_WAIT_V(6); PG8_BAR;
    } else {
        PG8_STAGE(PG8_SB(0, 0), cB, voffB); PG8_STAGE(PG8_SA(0, 0), cA, voffA); PG8_STAGE(PG8_SB(0, 1), cB + hstep, voffB); PG8_STAGE(PG8_SA(0, 1), cA + hstep, voffA);
        if (wr == 1) PG8_BAR;
        PG8_WAIT_V(4); PG8_BAR;
        PG8_STAGE(PG8_SB(1, 0), cB + kstep, voffB); PG8_STAGE(PG8_SA(1, 0), cA + kstep, voffA); PG8_STAGE(PG8_SB(1, 1), cB + hstep + kstep, voffB);
        PG8_WAIT_V(6); PG8_BAR;
    }
    for (;;) {
        const bool has_next = S.next(ui + 1, nxt);
        const char* nA = has_next ? (const char*)g.A + (size_t)nxt.pm * tstep : cA; const char* nB = has_next ? (const char*)g.Bt + (size_t)nxt.pn * tstep : cB;
        for (int t = 0; t < nt; t += 2) {
            const bool last = (t == nt - 2);
            const char* a1 = cA + (size_t)(t + 1) * kstep;
            const char* a2 = last ? nA : cA + (size_t)(t + 2) * kstep; const char* b2 = last ? nB : cB + (size_t)(t + 2) * kstep;
            const char* a3 = a2 + kstep; const char* b3 = b2 + kstep;
            if (last && has_next) S.a_ready(nxt);
            if constexpr (SP2) {
            PG8_LDB(B0, 0, 0); PG8_LDB(B1, 0, 1); PG8_SCHED; PG8_LDA(At, 0, 0); PG8_STAGE(PG8_SA(1, 1), a1 + hstep, voffA);
            PG8_WAIT_V(8); PG8_WAIT_L(0); PG8_BAR; PG8_MMA(0, 0, At, B0); PG8_MMA(0, 1, At, B1); PG8_BAR; PG8_SCHED;
            PG8_LDA(At, 0, 1); PG8_STAGE(PG8_SB(0, 0), b2, voffB); PG8_STAGE(PG8_SB(0, 1), b2 + hstep, voffB); PG8_STAGE(PG8_SA(0, 0), a2, voffA);
            PG8_WAIT_V(8); PG8_WAIT_L(0); PG8_BAR; PG8_MMA(1, 0, At, B0); PG8_MMA(1, 1, At, B1); PG8_BAR; PG8_SCHED;
            PG8_LDB(B0, 1, 0); PG8_LDB(B1, 1, 1); PG8_SCHED; PG8_LDA(At, 1, 0); PG8_STAGE(PG8_SA(0, 1), a2 + hstep, voffA);
            PG8_WAIT_V(8); PG8_WAIT_L(0); PG8_BAR; PG8_MMA(0, 0, At, B0); PG8_MMA(0, 1, At, B1); PG8_BAR; PG8_SCHED;
            PG8_LDA(At, 1, 1); PG8_STAGE(PG8_SB(1, 0), b3, voffB); PG8_STAGE(PG8_SB(1, 1), b3 + hstep, voffB); PG8_STAGE(PG8_SA(1, 0), a3, voffA);
            PG8_WAIT_V(8); PG8_WAIT_L(0); PG8_BAR; PG8_MMA(1, 0, At, B0); PG8_MMA(1, 1, At, B1); PG8_BAR; PG8_SCHED;
            } else {
            PG8_LDB(B0, 0, 0); PG8_SCHED; PG8_LDA(At, 0, 0); PG8_STAGE(PG8_SA(1, 1), a1 + hstep, voffA);
            PG8_WAIT_L(8); PG8_BAR; PG8_WAIT_L(0); PG8_MMA(0, 0, At, B0); PG8_BAR; PG8_SCHED;
            PG8_LDB(B1, 0, 1); PG8_STAGE(PG8_SB(0, 0), b2, voffB);
            PG8_BAR; PG8_WAIT_L(0); PG8_MMA(0, 1, At, B1); PG8_BAR;
            PG8_LDA(At, 0, 1); PG8_STAGE(PG8_SA(0, 0), a2, voffA);
            PG8_BAR; PG8_WAIT_L(0); PG8_MMA(1, 0, At, B0); PG8_BAR; PG8_SCHED;
            PG8_STAGE(PG8_SB(0, 1), b2 + hstep, voffB);
            PG8_WAIT_V(6); PG8_BAR; PG8_MMA(1, 1, At, B1); PG8_BAR;
            PG8_LDB(B0, 1, 0); PG8_SCHED; PG8_LDA(At, 1, 0); PG8_STAGE(PG8_SA(0, 1), a2 + hstep, voffA);
            PG8_WAIT_L(8); PG8_BAR; PG8_WAIT_L(0); PG8_MMA(0, 0, At, B0); PG8_BAR; PG8_SCHED;
            PG8_LDB(B1, 1, 1); PG8_STAGE(PG8_SB(1, 0), b3, voffB);
            PG8_BAR; PG8_WAIT_L(0); PG8_MMA(0, 1, At, B1); PG8_BAR;
            PG8_LDA(At, 1, 1); PG8_STAGE(PG8_SA(1, 0), a3, voffA);
            PG8_BAR; PG8_WAIT_L(0); PG8_MMA(1, 0, At, B0); PG8_BAR; PG8_SCHED;
            PG8_STAGE(PG8_SB(1, 1), b3 + hstep, voffB);
            PG8_WAIT_V(6); PG8_BAR; PG8_MMA(1, 1, At, B1); PG8_BAR;
            }
        }
        if constexpr (ALIGN_EPI) { if (wr == 0) PG8_BAR; }
        if constexpr (!Epi::AFTER_DRAIN) { E(acc, cur, wr, wc, fr, fq); S.done(cur); }
        if (!has_next) break;
#pragma unroll
        for (int a = 0; a < 2; ++a)
#pragma unroll
            for (int b = 0; b < 2; ++b)
#pragma unroll
                for (int m = 0; m < 4; ++m)
#pragma unroll
                    for (int n = 0; n < 2; ++n) acc[a][b][m][n] = (f32x4){0.f, 0.f, 0.f, 0.f};
        cur = nxt; cA = nA; cB = nB; ++ui;
        if constexpr (ALIGN_EPI) { if (wr == 1) PG8_BAR; }
    }
    PG8_WAIT_V(0);
    if constexpr (!ALIGN_EPI) { if (wr == 0) PG8_BAR; }
    PG8_BAR;
    if constexpr (Epi::AFTER_DRAIN) { E.fused(acc, cur, wr, wc, fr, fq, lds, wid, lane); S.done(cur); }
#undef PG8_SA
#undef PG8_SB
#undef PG8_STAGE
#undef PG8_LDA
#undef PG8_LDB
#undef PG8_MMA
#undef PG8_WAIT_V
#undef PG8_WAIT_L
#undef PG8_BAR
#undef PG8_SCHED
}
}
#define XB_TMO      128
#define XB_XCNT(j)  (256  + 64 * (j))
#define XB_XSUB(j)  (1280 + 64 * (j))
#define XB_XGEN(j)  (2304 + 64 * (j))
#define XB_TOP      3328
#define XB_TOPGEN   3392
#define XCD_BAR_WORDS 3456
#define XB_SPIN_CAP (1u << 18)

__device__ __forceinline__ unsigned xb_ld(unsigned* p)              { return __hip_atomic_load(p, __ATOMIC_RELAXED, __HIP_MEMORY_SCOPE_AGENT); }
__device__ __forceinline__ unsigned xb_add(unsigned* p, unsigned v) { return __hip_atomic_fetch_add(p, v, __ATOMIC_RELAXED, __HIP_MEMORY_SCOPE_AGENT); }
__device__ __forceinline__ unsigned xb_xcc_id() { return (unsigned)__builtin_amdgcn_s_getreg((3 << 11) | 20) & 0xFu; }
#define XB_SPIN(cond, bar) do { unsigned _sp = 0; while (cond) { __builtin_amdgcn_s_sleep(1); \
    if ((++_sp & 255u) == 0u) { if (xb_ld(&(bar)[XB_TMO])) break; if (_sp > XB_SPIN_CAP) { atomicAdd(&(bar)[XB_TMO], 1u); break; } } } } while (0)

struct XcdBarrier {
    unsigned* bar; unsigned x;
    volatile LAS unsigned* st;
};

__device__ __forceinline__ XcdBarrier xcd_barrier_post(unsigned* bar, volatile LAS unsigned* st) {
    XcdBarrier b; b.bar = bar; b.x = xb_xcc_id(); b.st = st;
    if (threadIdx.x == 0) (void)xb_add(&bar[XB_XCNT(b.x)], 1u);
    return b;
}
__device__ __forceinline__ void xcd_barrier_complete(unsigned* bar, unsigned x, unsigned& nloc, unsigned& nx) {
    const unsigned G = gridDim.x * gridDim.y * gridDim.z;
    unsigned sum, cnt, mine, sp = 0u;
    for (;;) {
        sum = 0u; cnt = 0u; mine = 0u;
#pragma unroll
        for (unsigned j = 0; j < 16; ++j) { const unsigned c = xb_ld(&bar[XB_XCNT(j)]); sum += c; cnt += (c > 0u) ? 1u : 0u; mine = (j == x) ? c : mine; }
        if (sum == G) break;
        __builtin_amdgcn_s_sleep(1);
        if ((++sp & 255u) == 0u) { if (xb_ld(&bar[XB_TMO])) break; if (sp > XB_SPIN_CAP) { atomicAdd(&bar[XB_TMO], 1u); break; } }
    }
    nloc = mine > 0u ? mine : 1u; nx = cnt > 0u ? cnt : 1u;
}

__device__ __forceinline__ void xcd_barrier(const XcdBarrier& b) {
    asm volatile("s_waitcnt vmcnt(0)" ::: "memory");
    __syncthreads();
    if (threadIdx.x == 0) {
        unsigned* bar = b.bar;
        __builtin_amdgcn_s_waitcnt(0);
        unsigned nloc = b.st[0], nx = b.st[1];
        if (nloc == 0u) { xcd_barrier_complete(bar, b.x, nloc, nx); b.st[0] = nloc; b.st[1] = nx; }
        const unsigned old = xb_add(&bar[XB_XSUB(b.x)], 1u);
        const unsigned gen = old / nloc;
        if (old + 1u == (gen + 1u) * nloc) {
            __builtin_amdgcn_fence(__ATOMIC_RELEASE, "agent");
            asm volatile("s_waitcnt vmcnt(0)" ::: "memory");
            const unsigned og = xb_add(&bar[XB_TOP], 1u);
            const unsigned tg = og / nx;
            if (og + 1u == (tg + 1u) * nx) xb_add(&bar[XB_TOPGEN], 1u);
            else XB_SPIN(xb_ld(&bar[XB_TOPGEN]) == tg, bar);
            __builtin_amdgcn_fence(__ATOMIC_ACQUIRE, "agent");
            xb_add(&bar[XB_XGEN(b.x)], 1u);
            asm volatile("s_waitcnt vmcnt(0)" ::: "memory");
        } else {
            XB_SPIN(xb_ld(&bar[XB_XGEN(b.x)]) == gen, bar);
            __builtin_amdgcn_fence(__ATOMIC_ACQUIRE, "agent");
            asm volatile("s_waitcnt vmcnt(0)" ::: "memory");
        }
    }
    __syncthreads();
}

constexpr int NWAVES = 8;
#ifndef LBW
#define LBW 2
#endif
constexpr int D = 1024, NP = 16384, NS = 2048, MT = NP + NS;
constexpr int PAST = 4096, NB = 32;
constexpr int WIN_LD = 4104;
constexpr float EPSN = 1e-6f;
constexpr float LOG2E = 1.4426950408889634f;
constexpr float C2 = 0.125f * LOG2E;
constexpr float NEGBIG = -1e30f;
constexpr float SKIP_THR = 48.0f;
constexpr float RESC_THR = 8.0f;
constexpr size_t O_FKP = 18874368, O_FVP = 27262976, O_LFP = 35651584, O_DKP = 35782656, O_DVP = 44171264, O_FKS = 52559872, O_FVS = 53608448, O_LFS = 54657024, O_DKS = 54673408, O_DVS = 55721984, O_TOTAL = 56770560;
constexpr size_t MiB = 1u << 20;
constexpr size_t WS_CTL = 0, CTL_ZERO_BYTES = 65536;
constexpr size_t WS_WTIN = 2 * MiB, WS_WTOUT = 10 * MiB, WS_LCUM = 12 * MiB, WS_TTOT = 13 * MiB, WS_LC = 14 * MiB, WS_TC = 18 * MiB, WS_SS = 19 * MiB;
constexpr size_t WS_H = 32 * MiB;
constexpr size_t WS_SEG = 68 * MiB, SEG_BYTES = 18 * MiB;
constexpr size_t WS_STASH = 212 * MiB;
constexpr size_t WS_OUTF = 244 * MiB;
constexpr size_t WS_END = 316 * MiB;
constexpr int CW_BAR = 4096;
constexpr int CW_Q0 = 64, CW_Q1 = 128, CW_Q2 = 192, CW_Q3 = 256;
constexpr int CW_NRM = 512;
constexpr int RING_BYTES = 131072;
constexpr int MISC_OFF = RING_BYTES;
constexpr int LDS_BYTES = 147456;

typedef unsigned short bf16;
typedef unsigned v4u __attribute__((ext_vector_type(4)));
typedef float f32x4 __attribute__((ext_vector_type(4)));
typedef float f32x16 __attribute__((ext_vector_type(16)));
typedef short bf16x8 __attribute__((ext_vector_type(8)));
typedef short s16x4 __attribute__((ext_vector_type(4)));
typedef short v4i16_t __attribute__((ext_vector_type(4)));
#define LDS_WAIT() asm volatile("s_waitcnt lgkmcnt(0)" ::: "memory")

__device__ __forceinline__ unsigned f2bf(float f) { unsigned u = __builtin_bit_cast(unsigned, f); return (u + 0x7fffu + ((u >> 16) & 1u)) >> 16; }
typedef float f32x2_t __attribute__((ext_vector_type(2))); typedef __bf16 bf16x2_t __attribute__((ext_vector_type(2)));
__device__ __forceinline__ unsigned pk2(float lo, float hi) { f32x2_t v = {lo, hi}; bf16x2_t b = __builtin_convertvector(v, bf16x2_t); return __builtin_bit_cast(unsigned, b); }
__device__ __forceinline__ float bf2f(unsigned short b) { return __builtin_bit_cast(float, (unsigned)b << 16); }
__device__ __forceinline__ float wave_sum(float v) {
#pragma unroll
    for (int o = 1; o < 64; o <<= 1) v += __shfl_xor(v, o);
    return v;
}
__device__ __forceinline__ unsigned ldu(const unsigned* p) { return __hip_atomic_load(p, __ATOMIC_RELAXED, __HIP_MEMORY_SCOPE_AGENT); }
__device__ __forceinline__ int crow(int r, int hi) { return (r & 3) + 8 * (r >> 2) + 4 * hi; }

struct Args {
    const float* x_p; const float* x_s; const float* ck; const float* cv; const float* clf; const float* cdk; const float* cdv;
    const float* g_pre; const float* w_in; const float* b_f; const float* lq1; const float* lk1; const float* lq2; const float* lk2;
    const float* subln; const float* w_out; const float* g_post; const float* relb;
    float* out; unsigned char* ws;
};

__device__ __forceinline__ void p0_transpose_item(const float* W, int ldw, int K, int nblk, int split, int skip, bf16* WT, LAS float* scr, int item, int lane) {
    const int kb = item / nblk, nb = item % nblk, k0 = 64 * kb, n0 = 32 * nb, w0 = n0 + (n0 >= split ? skip : 0);
#pragma unroll 8
    for (int i = 0; i < 32; ++i) { const int kk = 2 * i + (lane >> 5); scr[kk * 33 + (lane & 31)] = W[(size_t)(k0 + kk) * ldw + w0 + (lane & 31)]; }
    LDS_WAIT(); asm volatile("" ::: "memory");
    const int c = lane & 7;
#pragma unroll
    for (int j = 0; j < 4; ++j) { const int n = (lane >> 3) + 8 * j; const LAS float* s = scr + (8 * c) * 33 + n;
        v4u o; o.x = pk2(s[0 * 33], s[1 * 33]); o.y = pk2(s[2 * 33], s[3 * 33]); o.z = pk2(s[4 * 33], s[5 * 33]); o.w = pk2(s[6 * 33], s[7 * 33]);
        *(v4u*)(WT + (size_t)(n0 + n) * K + k0 + 8 * c) = o; }
    LDS_WAIT(); asm volatile("" ::: "memory");
}

__device__ __forceinline__ void p0_prologue(const Args& A, LAS unsigned char* lds, int vcu, int G) {
    const int tid = threadIdx.x, lane = tid & 63, wave = __builtin_amdgcn_readfirstlane(tid >> 6);
    const int gw = vcu * NWAVES + wave, NGW = G * NWAVES;
    {
        LAS float* scr = (LAS float*)(lds + wave * 16384);
        bf16* WTin = (bf16*)(A.ws + WS_WTIN); bf16* WTout = (bf16*)(A.ws + WS_WTOUT);
        constexpr int I_IN = (D / 64) * (4096 / 32), I_OUT = (D / 64) * (D / 32);
        for (int it = gw; it < I_IN + I_OUT; it += NGW) {
            if (it < I_IN) p0_transpose_item(A.w_in, WIN_LD, D, 4096 / 32, 1536, 8, WTin, scr, it, lane);
            else p0_transpose_item(A.w_out, D, D, D / 32, 1 << 30, 0, WTout, scr, it - I_IN, lane);
        }
    }
    {
        float* LC = (float*)(A.ws + WS_LC); float* TC = (float*)(A.ws + WS_TC);
        for (int ch = gw; ch < NB * 64; ch += NGW) {
            const float* src = A.clf + (size_t)ch * 512 + lane * 8;
            f32x4 a = *(const f32x4*)src, b = *(const f32x4*)(src + 4);
            float v[8] = {a[0], a[1], a[2], a[3], b[0], b[1], b[2], b[3]};
#pragma unroll
            for (int o = 1; o < 64; o <<= 1) {
#pragma unroll
                for (int j = 0; j < 8; ++j) { const float t = __shfl_up(v[j], o); if (lane >= o) v[j] += t; }
            }
            float* dst = LC + (size_t)ch * 512 + lane * 8;
            *(f32x4*)dst = (f32x4){v[0], v[1], v[2], v[3]}; *(f32x4*)(dst + 4) = (f32x4){v[4], v[5], v[6], v[7]};
            if (lane == 63) { float* t = TC + (size_t)ch * 8; *(f32x4*)t = (f32x4){v[0], v[1], v[2], v[3]}; *(f32x4*)(t + 4) = (f32x4){v[4], v[5], v[6], v[7]}; }
        }
    }
    __syncthreads();
    {
        LAS float* wff = (LAS float*)lds;
        LAS float* lfb = (LAS float*)(lds + 32768);
        for (int i = tid; i < 1024 * 8; i += 512) wff[i] = A.w_in[(size_t)(i >> 3) * WIN_LD + 1536 + (i & 7)];
        __syncthreads();
        bf16* H = (bf16*)(A.ws + WS_H); float* LCUM = (float*)(A.ws + WS_LCUM); float* TTOT = (float*)(A.ws + WS_TTOT);
        f32x4 g[4];
#pragma unroll
        for (int j = 0; j < 4; ++j) g[j] = *(const f32x4*)(A.g_pre + 4 * lane + 256 * j);
        const float bfv = A.b_f[lane & 7];
        for (int blk = vcu; blk < MT / 64; blk += G) {
            for (int i = 0; i < 8; ++i) {
                const int rl = wave * 8 + i, row = blk * 64 + rl;
                const float* xr = (row < NP) ? (A.x_p + (size_t)row * D) : (A.x_s + (size_t)(row - NP) * D);
                f32x4 v[4]; float s = 0.f;
#pragma unroll
                for (int j = 0; j < 4; ++j) { v[j] = *(const f32x4*)(xr + 4 * lane + 256 * j); s += (v[j][0] * v[j][0] + v[j][1] * v[j][1]) + (v[j][2] * v[j][2] + v[j][3] * v[j][3]); }
                const float rstd = 1.0f / sqrtf(wave_sum(s) * (1.0f / D) + EPSN);
                float ff[8] = {0.f, 0.f, 0.f, 0.f, 0.f, 0.f, 0.f, 0.f};
                unsigned long long* o8 = (unsigned long long*)(H + (size_t)row * D) + lane;
#pragma unroll
                for (int j = 0; j < 4; ++j) {
                    const f32x4 hv = v[j] * rstd * g[j];
                    o8[64 * j] = (unsigned long long)pk2(hv[0], hv[1]) | ((unsigned long long)pk2(hv[2], hv[3]) << 32);
#pragma unroll
                    for (int e = 0; e < 4; ++e) { const LAS float* wr = wff + (size_t)(256 * j + 4 * lane + e) * 8; const f32x4 w0 = *(const LAS f32x4*)wr, w1 = *(const LAS f32x4*)(wr + 4);
                        ff[0] += hv[e] * w0[0]; ff[1] += hv[e] * w0[1]; ff[2] += hv[e] * w0[2]; ff[3] += hv[e] * w0[3];
                        ff[4] += hv[e] * w1[0]; ff[5] += hv[e] * w1[1]; ff[6] += hv[e] * w1[2]; ff[7] += hv[e] * w1[3]; }
                }
                float z = 0.f;
#pragma unroll
                for (int j = 0; j < 8; ++j) { const float t = wave_sum(ff[j]); z = ((lane & 7) == j) ? t : z; }
                z += bfv;
                const float lf = fminf(z, 0.f) - log1pf(expf(-fabsf(z)));
                if (lane < 8) { lfb[rl * 8 + lane] = lf;
                    if (row < NP) A.out[O_LFP + (size_t)row * 8 + lane] = lf; else A.out[O_LFS + (size_t)(row - NP) * 8 + lane] = lf; }
            }
            __syncthreads();
            if (tid < 8) { float run = 0.f;
                for (int r = 0; r < 64; ++r) { run += lfb[r * 8 + tid]; LCUM[(size_t)(blk * 64 + r) * 8 + tid] = run; }
                TTOT[blk * 8 + tid] = run; }
            __syncthreads();
        }
    }
}

constexpr int AL_K = 0, AL_V = 16384, AL_STG = 0, AL_CK = 65536, AL_WSF = 66048, AL_TOT = 68096, AL_DD = 69184, AL_TAB = 70272, AL_MISC = 73344;

__device__ __forceinline__ s16x4 vtr(const LAS unsigned char* p) { return __builtin_bit_cast(s16x4, __builtin_amdgcn_ds_read_tr16_b64_v4i16((LAS v4i16_t*)p)); }
__device__ __forceinline__ bf16x8 cvt8(const f32x4 a, const f32x4 b) {
    v4u w; w.x = pk2(a[0], a[1]); w.y = pk2(a[2], a[3]); w.z = pk2(b[0], b[1]); w.w = pk2(b[2], b[3]); return __builtin_bit_cast(bf16x8, w); }

struct AttnCtx {
    const bf16 *QF, *KF, *VF, *GF, *DQ, *DK, *DV, *GD; bf16* MIX;
    const float *LCUM, *TTOT, *LC, *TC;
    const float *ck, *cv, *cdk, *cdv;
    const float* subln; float lam; float* stash; const unsigned* nrm;
};

template <int KIND>
__device__ __forceinline__ void attn_unit(const AttnCtx& C, int u, LAS unsigned char* lds) {
    constexpr bool FOX = (KIND == 0 || KIND == 2), SAMPLE = (KIND >= 2);
    constexpr int DV = FOX ? 64 : 128, NDB = DV / 32, NMAP = FOX ? 1 : 2, NVC = DV / 64;
    int tid = threadIdx.x; asm volatile("" : "+v"(tid));
    const int lane = tid & 63, r32 = lane & 31, hi = lane >> 5; const int wid = __builtin_amdgcn_readfirstlane(tid >> 6);
    int h, qb = 0, b = 0, NT, qrow, qpos, tref;
    if (KIND == 0) { h = u & 7; qb = 63 - (u >> 3); }
    else if (KIND == 1) { h = u & 3; qb = 63 - (u >> 2); }
    else if (KIND == 2) { h = u & 7; b = u >> 3; }
    else { h = u & 3; b = u >> 2; }
    if (!SAMPLE) { NT = 4 * qb + 4; qrow = 256 * qb + 32 * wid + r32; qpos = qrow; tref = 4 * qb; }
    else { NT = 65; qrow = NP + b * 64 + 32 * (wid & 1) + r32; qpos = PAST + 32 * (wid & 1) + r32; tref = 64; }
    const bool compute_wave = SAMPLE ? (wid < 2) : true;
    LAS float* ckt = (LAS float*)(lds + AL_CK); LAS float* wsf = (LAS float*)(lds + AL_WSF) + wid * 64;
    LAS float* tot = (LAS float*)(lds + AL_TOT); LAS float* dd = (LAS float*)(lds + AL_DD); const LAS float* tab = (const LAS float*)(lds + AL_TAB) + h * 192;
    float cq = 0.f;
    if (FOX) {
        __syncthreads();
        for (int c = tid; c < NT; c += 512) { float t;
            if (!SAMPLE) t = C.TTOT[c * 8 + h]; else t = (c < 64) ? C.TC[(size_t)(b * 64 + c) * 8 + h] : C.TTOT[(256 + b) * 8 + h];
            tot[c] = t; }
        __syncthreads();
        if (wid == 0) {
            float loc[4]; float run = 0.f;
#pragma unroll
            for (int j = 0; j < 4; ++j) { const int c = tref - 1 - (4 * lane + j); const float v = (c >= 0) ? tot[c] : 0.f; run += v; loc[j] = run; }
            float incl = run;
#pragma unroll
            for (int o = 1; o < 64; o <<= 1) { const float t = __shfl_up(incl, o); if (lane >= o) incl += t; }
            const float excl = incl - run;
#pragma unroll
            for (int j = 0; j < 4; ++j) { const int c = tref - 1 - (4 * lane + j); if (c >= 0) dd[c] = -(excl + loc[j]); }
            if (lane == 0) { float s = 0.f; dd[tref] = 0.f; for (int c = tref + 1; c < NT; ++c) { s += tot[c - 1]; dd[c] = s; } }
            if (KIND == 0) {
                const float qn2 = __uint_as_float(ldu(C.nrm + h * 2)) + __uint_as_float(ldu(C.nrm + h * 2 + 1)), kn2 = __uint_as_float(ldu(C.nrm + 16 + h * 2)) + __uint_as_float(ldu(C.nrm + 16 + h * 2 + 1));
                const float thr_nat = (SKIP_THR + 2.0f * 1.01f * sqrtf(qn2 * kn2)) * (1.0f / LOG2E);
                const float lq0 = __uint_as_float(ldu((const unsigned*)(C.LCUM + (size_t)(256 * qb) * 8 + h)));
                LDS_WAIT();
                int cnt = 0;
#pragma unroll
                for (int j = 0; j < 4; ++j) { const int c = tref - 1 - (4 * lane + j); if (c >= 0 && (lq0 - dd[c + 1]) <= -thr_nat) ++cnt; }
#pragma unroll
                for (int o = 1; o < 64; o <<= 1) cnt += __shfl_xor(cnt, o);
                if (lane == 0) ((LAS int*)(lds + AL_MISC))[8] = cnt;
            }
        }
        __syncthreads();
        const int qc = SAMPLE ? 64 : (qrow >> 6);
        cq = (dd[qc] + C.LCUM[(size_t)qrow * 8 + h]) * LOG2E;
    }
    int t_start = 0;
    if (KIND == 0) t_start = ((const LAS int*)(lds + AL_MISC))[8];
    const int kkey = (tid & 7) + 8 * (tid >> 6), kc = (tid >> 3) & 7; const int kdst = kc * 1024 + kkey * 16;
    for (int map = 0; map < NMAP; ++map) {
        bf16x8 qr[4];
        { const bf16* qsrc = FOX ? (C.QF + (size_t)qrow * 512 + h * 64) : (C.DQ + (size_t)qrow * 512 + h * 128 + map * 64);
#pragma unroll
          for (int d0 = 0; d0 < 4; ++d0) qr[d0] = *(const bf16x8*)(qsrc + d0 * 16 + hi * 8); }
        f32x16 o[NDB];
#pragma unroll
        for (int d = 0; d < NDB; ++d) o[d] = (f32x16){0.f,0.f,0.f,0.f,0.f,0.f,0.f,0.f,0.f,0.f,0.f,0.f,0.f,0.f,0.f,0.f};
        float m_run = NEGBIG, l_run = 0.f;
        v4u kraw[2]; v4u vraw[NVC][2]; float ckraw = 0.f;
        kraw[0] = (v4u){0,0,0,0}; kraw[1] = (v4u){0,0,0,0};
#pragma unroll
        for (int i = 0; i < NVC; ++i) { vraw[i][0] = (v4u){0,0,0,0}; vraw[i][1] = (v4u){0,0,0,0}; }
        auto stage_load = [&](int t) {
            const bool f32src = SAMPLE && (t < 64);
            if (f32src) {
                const float* kp;
                if (FOX) kp = C.ck + ((size_t)(b * PAST + t * 64 + kkey) * 8 + h) * 64 + kc * 8;
                else kp = C.cdk + ((size_t)(b * PAST + t * 64 + kkey) * 4 + h) * 128 + map * 64 + kc * 8;
                kraw[0] = *(const v4u*)kp; kraw[1] = *(const v4u*)(kp + 4);
#pragma unroll
                for (int i = 0; i < NVC; ++i) { const int idx = tid + 512 * i, vkey = idx / (DV / 8), vc = idx % (DV / 8);
                    const float* vp = FOX ? (C.cv + ((size_t)(b * PAST + t * 64 + vkey) * 8 + h) * 64 + vc * 8) : (C.cdv + ((size_t)(b * PAST + t * 64 + vkey) * 4 + h) * 128 + vc * 8);
                    vraw[i][0] = *(const v4u*)vp; vraw[i][1] = *(const v4u*)(vp + 4); }
            } else {
                const size_t krow = SAMPLE ? (size_t)(NP + b * 64 + kkey) : (size_t)(t * 64 + kkey);
                const bf16* kp = FOX ? (C.KF + krow * 512 + h * 64 + kc * 8) : (C.DK + krow * 512 + h * 128 + map * 64 + kc * 8);
                kraw[0] = *(const v4u*)kp;
#pragma unroll
                for (int i = 0; i < NVC; ++i) { const int idx = tid + 512 * i, vkey = idx / (DV / 8), vc = idx % (DV / 8);
                    const size_t vrow = SAMPLE ? (size_t)(NP + b * 64 + vkey) : (size_t)(t * 64 + vkey);
                    const bf16* vp = FOX ? (C.VF + vrow * 512 + h * 64 + vc * 8) : (C.DV + vrow * 512 + h * 128 + vc * 8);
                    vraw[i][0] = *(const v4u*)vp; }
            }
            if (FOX && tid < 64) {
                float lv;
                if (SAMPLE) lv = (t < 64) ? C.LC[(size_t)(b * PAST + t * 64 + tid) * 8 + h] : C.LCUM[(size_t)(NP + b * 64 + tid) * 8 + h];
                else lv = C.LCUM[(size_t)(t * 64 + tid) * 8 + h];
                ckraw = lv;
            }
        };
        auto stage_write = [&](int t, int buf) {
            const bool f32src = SAMPLE && (t < 64);
            LAS unsigned char* kb = lds + AL_K + buf * 8192; LAS unsigned char* vb = lds + AL_V + buf * 16384;
            if (f32src) *(LAS bf16x8*)(kb + kdst) = cvt8(__builtin_bit_cast(f32x4, kraw[0]), __builtin_bit_cast(f32x4, kraw[1])); else *(LAS v4u*)(kb + kdst) = kraw[0];
#pragma unroll
            for (int i = 0; i < NVC; ++i) { const int idx = tid + 512 * i, vkey = idx / (DV / 8), vc = idx % (DV / 8);
                const int vdst = (vc >> 2) * 4096 + (vkey >> 4) * 1024 + (vkey & 15) * 64 + (vc & 3) * 16;
                if (f32src) *(LAS bf16x8*)(vb + vdst) = cvt8(__builtin_bit_cast(f32x4, vraw[i][0]), __builtin_bit_cast(f32x4, vraw[i][1])); else *(LAS v4u*)(vb + vdst) = vraw[i][0]; }
            if (FOX && tid < 64) ckt[buf * 64 + tid] = (dd[t] + ckraw) * LOG2E;
        };
        __syncthreads();
        stage_load(t_start); stage_write(t_start, t_start & 1);
        __syncthreads();
        for (int t = t_start; t < NT; ++t) {
            const int buf = t & 1;
            if (t + 1 < NT) stage_load(t + 1);
            if (compute_wave) {
                const LAS unsigned char* kt = lds + AL_K + buf * 8192; const LAS unsigned char* vt = lds + AL_V + buf * 16384;
                f32x16 p0, p1;
                if (FOX) {
#pragma unroll
                    for (int gq = 0; gq < 4; ++gq) { const f32x4 a = *(const LAS f32x4*)(ckt + buf * 64 + 8 * gq + 4 * hi), bq = *(const LAS f32x4*)(ckt + buf * 64 + 32 + 8 * gq + 4 * hi);
#pragma unroll
                        for (int e = 0; e < 4; ++e) { p0[4 * gq + e] = cq - a[e]; p1[4 * gq + e] = cq - bq[e]; } }
                } else {
                    const bool far_t = SAMPLE ? (t <= 61) : (t <= 4 * qb - 3);
                    const float c15 = far_t ? tab[0] : 0.f;
#pragma unroll
                    for (int r = 0; r < 16; ++r) { p0[r] = c15; p1[r] = c15; }
                }
                const LAS unsigned char* kbp = kt + hi * 1024 + r32 * 16;
#pragma unroll
                for (int d0 = 0; d0 < 4; ++d0) {
                    const bf16x8 b0 = *(const LAS bf16x8*)(kbp + d0 * 2048), b1 = *(const LAS bf16x8*)(kbp + d0 * 2048 + 512);
                    p0 = __builtin_amdgcn_mfma_f32_32x32x16_bf16(b0, qr[d0], p0, 0, 0, 0);
                    p1 = __builtin_amdgcn_mfma_f32_32x32x16_bf16(b1, qr[d0], p1, 0, 0, 0);
                }
                if (!FOX) {
                    const bool far_t = SAMPLE ? (t <= 61) : (t <= 4 * qb - 3);
#ifndef T_NONEAR
                    if (!far_t) {
#pragma unroll
                        for (int r = 0; r < 16; ++r) { const int rel0 = t * 64 + crow(r, hi) - qpos; int i0 = rel0 < -128 ? -128 : rel0; i0 = i0 > 63 ? 63 : i0; int i1 = rel0 + 32 < -128 ? -128 : rel0 + 32; i1 = i1 > 63 ? 63 : i1;
                            p0[r] += tab[i0 + 128]; p1[r] += tab[i1 + 128]; }
                    }
#endif
                    if (!SAMPLE) { if (t > (qpos >> 6)) {
#pragma unroll
                        for (int r = 0; r < 16; ++r) { p0[r] = NEGBIG; p1[r] = NEGBIG; } } }
                } else {
                    const bool band = SAMPLE ? (t == 64) : (t >= 4 * qb);
                    if (band) { const int kb0 = (SAMPLE ? PAST : t * 64);
#pragma unroll
                        for (int r = 0; r < 16; ++r) { const int kv = kb0 + crow(r, hi); if (kv > qpos) p0[r] = NEGBIG; if (kv + 32 > qpos) p1[r] = NEGBIG; } }
                }
                float rm = fmaxf(p0[0], p1[0]);
#pragma unroll
                for (int r = 1; r < 16; ++r) rm = fmaxf(rm, fmaxf(p0[r], p1[r]));
                rm = fmaxf(rm, __shfl_xor(rm, 32));
                if (__any(rm > m_run + RESC_THR)) {
                    const float m_new = fmaxf(m_run, rm); const float alpha = __builtin_amdgcn_exp2f(m_run - m_new); m_run = m_new;
                    l_run *= alpha;
                    if (hi == 0) wsf[r32] = alpha;
#pragma unroll
                    for (int gq = 0; gq < 4; ++gq) { const f32x4 a = *(const LAS f32x4*)(wsf + 8 * gq + 4 * hi);
#pragma unroll
                        for (int d = 0; d < NDB; ++d)
#pragma unroll
                            for (int e = 0; e < 4; ++e) o[d][4 * gq + e] *= a[e]; }
                }
                float rs = 0.f;
#pragma unroll
                for (int r = 0; r < 16; ++r) { p0[r] = __builtin_amdgcn_exp2f(p0[r] - m_run); p1[r] = __builtin_amdgcn_exp2f(p1[r] - m_run); rs += p0[r] + p1[r]; }
                l_run += rs;
                v4u pw[4];
                pw[0] = (v4u){pk2(p0[0], p0[1]), pk2(p0[2], p0[3]), pk2(p0[4], p0[5]), pk2(p0[6], p0[7])};
                pw[1] = (v4u){pk2(p0[8], p0[9]), pk2(p0[10], p0[11]), pk2(p0[12], p0[13]), pk2(p0[14], p0[15])};
                pw[2] = (v4u){pk2(p1[0], p1[1]), pk2(p1[2], p1[3]), pk2(p1[4], p1[5]), pk2(p1[6], p1[7])};
                pw[3] = (v4u){pk2(p1[8], p1[9]), pk2(p1[10], p1[11]), pk2(p1[12], p1[13]), pk2(p1[14], p1[15])};
                const LAS unsigned char* vp = vt + ((lane >> 4) & 1) * 32 + (lane & 3) * 8 + (4 * hi + ((lane & 15) >> 2)) * 64;
#pragma unroll
                for (int d = 0; d < NDB; ++d)
#pragma unroll
                    for (int ks = 0; ks < 4; ++ks) {
                        const s16x4 lo = vtr(vp + d * 4096 + ks * 1024), hh = vtr(vp + d * 4096 + ks * 1024 + 512);
                        const bf16x8 vf = (bf16x8){lo[0], lo[1], lo[2], lo[3], hh[0], hh[1], hh[2], hh[3]};
                        o[d] = __builtin_amdgcn_mfma_f32_32x32x16_bf16(__builtin_bit_cast(bf16x8, pw[ks]), vf, o[d], 0, 0, 0);
                        if (ks == 3) __builtin_amdgcn_sched_barrier(0);
                    }
            }
            if (t + 1 < NT) stage_write(t + 1, buf ^ 1);
            __syncthreads();
        }
        if (compute_wave) {
            int tidf = threadIdx.x; asm volatile("" : "+v"(tidf));
            const int lanef = tidf & 63;
            float lt = l_run + __shfl_xor(l_run, 32);
            const float inv = 1.0f / lt;
            if (hi == 0) wsf[r32] = inv;
            float rinv[16];
#pragma unroll
            for (int gq = 0; gq < 4; ++gq) { const f32x4 a = *(const LAS f32x4*)(wsf + 8 * gq + 4 * hi); rinv[4 * gq] = a[0]; rinv[4 * gq + 1] = a[1]; rinv[4 * gq + 2] = a[2]; rinv[4 * gq + 3] = a[3]; }
            const int rowb = SAMPLE ? (NP + b * 64 + 32 * (wid & 1)) : (256 * qb + 32 * wid);
            if (!FOX && map == 0) {
                f32x4* st = (f32x4*)(C.stash + ((size_t)blockIdx.x * 512 + tidf) * (NDB * 16));
#pragma unroll
                for (int d = 0; d < NDB; ++d)
#pragma unroll
                    for (int gq = 0; gq < 4; ++gq) st[d * 4 + gq] = (f32x4){o[d][4 * gq] * rinv[4 * gq], o[d][4 * gq + 1] * rinv[4 * gq + 1], o[d][4 * gq + 2] * rinv[4 * gq + 2], o[d][4 * gq + 3] * rinv[4 * gq + 3]};
            } else {
                LAS bf16* stg = (LAS bf16*)(lds + AL_STG) + wid * (32 * DV);
                if (FOX) {
#pragma unroll
                    for (int d = 0; d < NDB; ++d)
#pragma unroll
                        for (int r = 0; r < 16; ++r) stg[crow(r, hi) * DV + 32 * d + r32] = (bf16)f2bf(o[d][r] * rinv[r]);
                } else {
                    const f32x4* st = (const f32x4*)(C.stash + ((size_t)blockIdx.x * 512 + tidf) * (NDB * 16));
#pragma unroll
                    for (int d = 0; d < NDB; ++d)
#pragma unroll
                        for (int gq = 0; gq < 4; ++gq) { const f32x4 s1 = st[d * 4 + gq];
#pragma unroll
                            for (int e = 0; e < 4; ++e) { const int r = 4 * gq + e; stg[crow(r, hi) * DV + 32 * d + r32] = (bf16)f2bf(s1[e] - C.lam * (o[d][r] * rinv[r])); } }
                }
                LDS_WAIT(); asm volatile("" ::: "memory");
                constexpr int LPR = DV / 8;
                constexpr int RPP = 64 / LPR;
                const int cl = lanef % LPR;
#pragma unroll
                for (int ps = 0; ps < 32 / RPP; ++ps) {
                    const int rl = ps * RPP + lanef / LPR; const size_t row = (size_t)(rowb + rl);
                    const v4u sv = *(const LAS v4u*)(stg + rl * DV + cl * 8);
                    float xv[8];
                    xv[0] = __builtin_bit_cast(float, sv.x << 16); xv[1] = __builtin_bit_cast(float, sv.x & 0xffff0000u); xv[2] = __builtin_bit_cast(float, sv.y << 16); xv[3] = __builtin_bit_cast(float, sv.y & 0xffff0000u);
                    xv[4] = __builtin_bit_cast(float, sv.z << 16); xv[5] = __builtin_bit_cast(float, sv.z & 0xffff0000u); xv[6] = __builtin_bit_cast(float, sv.w << 16); xv[7] = __builtin_bit_cast(float, sv.w & 0xffff0000u);
                    const bf16* gp = FOX ? (C.GF + row * 512 + h * 64 + cl * 8) : (C.GD + row * 512 + h * 128 + cl * 8);
                    const v4u gv = *(const v4u*)gp;
                    float gg[8];
                    gg[0] = __builtin_bit_cast(float, gv.x << 16); gg[1] = __builtin_bit_cast(float, gv.x & 0xffff0000u); gg[2] = __builtin_bit_cast(float, gv.y << 16); gg[3] = __builtin_bit_cast(float, gv.y & 0xffff0000u);
                    gg[4] = __builtin_bit_cast(float, gv.z << 16); gg[5] = __builtin_bit_cast(float, gv.z & 0xffff0000u); gg[6] = __builtin_bit_cast(float, gv.w << 16); gg[7] = __builtin_bit_cast(float, gv.w & 0xffff0000u);
                    if (!FOX) {
                        float sq = 0.f;
#pragma unroll
                        for (int e = 0; e < 8; ++e) sq += xv[e] * xv[e];
#pragma unroll
                        for (int s = 1; s < LPR; s <<= 1) sq += __shfl_xor(sq, s);
                        const float rs = (1.0f / sqrtf(sq * (1.0f / 128.0f) + EPSN)) * 0.8f;
                        const f32x4 s0 = *(const f32x4*)(C.subln + cl * 8), s1 = *(const f32x4*)(C.subln + cl * 8 + 4);
#pragma unroll
                        for (int e = 0; e < 4; ++e) { xv[e] *= rs * s0[e]; xv[4 + e] *= rs * s1[e]; }
                    }
                    v4u ov; ov.x = pk2(xv[0] * gg[0], xv[1] * gg[1]); ov.y = pk2(xv[2] * gg[2], xv[3] * gg[3]); ov.z = pk2(xv[4] * gg[4], xv[5] * gg[5]); ov.w = pk2(xv[6] * gg[6], xv[7] * gg[7]);
                    bf16* op = FOX ? (C.MIX + row * 1024 + h * 64 + cl * 8) : (C.MIX + row * 1024 + 512 + h * 128 + cl * 8);
                    *(v4u*)op = ov;
                }
            }
        }
    }
}

template <int KIND>
__device__ __forceinline__ void attn_queue(const AttnCtx& C, unsigned* head, int nunits, LAS unsigned char* lds) {
    volatile LAS unsigned* slot = (volatile LAS unsigned*)(lds + AL_MISC);
    for (;;) {
        __syncthreads();
        if (threadIdx.x == 0) slot[0] = __hip_atomic_fetch_add(head, 1u, __ATOMIC_RELAXED, __HIP_MEMORY_SCOPE_AGENT);
        __syncthreads();
        const unsigned u = slot[0];
        if (u >= (unsigned)nunits) break;
        attn_unit<KIND>(C, (int)u, lds);
    }
}

__device__ __forceinline__ int t5_bucket(int rel) {
    const int n = rel < 0 ? -rel : rel; int bk;
    if (n < 8) bk = n; else bk = n < 12 ? 8 : n < 16 ? 9 : n < 23 ? 10 : n < 32 ? 11 : n < 46 ? 12 : n < 64 ? 13 : n < 91 ? 14 : 15;
    return bk + (rel > 0 ? 16 : 0);
}

__global__ void __launch_bounds__(NWAVES * 64, LBW) fwd_kernel(Args A) {
    extern __shared__ __attribute__((aligned(16))) unsigned char lds_raw[];
    LAS unsigned char* lds = (LAS unsigned char*)lds_raw;
    const int tid = threadIdx.x, lane = tid & 63; const int wave = __builtin_amdgcn_readfirstlane(tid >> 6);
    const int G = gridDim.x; const int bx = blockIdx.x; const int vcu = (G % 8 == 0) ? (bx % 8) * (G / 8) + bx / 8 : bx;
    volatile LAS unsigned* MISC = (volatile LAS unsigned*)(lds + MISC_OFF);
    for (int i = tid; i < (LDS_BYTES - MISC_OFF) / 4; i += NWAVES * 64) MISC[i] = 0u;
    __syncthreads();
    unsigned* ctl = (unsigned*)(A.ws + WS_CTL);
    XcdBarrier bar = xcd_barrier_post(ctl + CW_BAR, MISC + 8);

    p0_prologue(A, lds, vcu, G);
    xcd_barrier(bar);

    {
        pg8::Gemm g{(const pg8::bf16_t*)(A.ws + WS_H), (const pg8::bf16_t*)(A.ws + WS_WTIN), MT, 4096, D};
        pg8::StaticOrder S; S.init(MT, 4096, G, bx);
        pg8::EpiIn E{(pg8::bf16_t*)(A.ws + WS_SEG), SEG_BYTES / 2, A.out, C2, ctl + CW_NRM};
        pg8::gemm_phase<pg8::EpiIn, pg8::StaticOrder, true, true>(lds, g, S, E);
    }
    xcd_barrier(bar);

    {
        AttnCtx C;
        C.QF = (const bf16*)(A.ws + WS_SEG); C.KF = C.QF + SEG_BYTES / 2; C.VF = C.KF + SEG_BYTES / 2; C.GF = C.VF + SEG_BYTES / 2;
        C.DQ = C.GF + SEG_BYTES / 2; C.DK = C.DQ + SEG_BYTES / 2; C.DV = C.DK + SEG_BYTES / 2; C.GD = C.DV + SEG_BYTES / 2;
        C.MIX = (bf16*)(A.ws + WS_H);
        C.LCUM = (const float*)(A.ws + WS_LCUM); C.TTOT = (const float*)(A.ws + WS_TTOT); C.LC = (const float*)(A.ws + WS_LC); C.TC = (const float*)(A.ws + WS_TC);
        C.ck = A.ck; C.cv = A.cv; C.cdk = A.cdk; C.cdv = A.cdv; C.subln = A.subln; C.stash = (float*)(A.ws + WS_STASH); C.nrm = ctl + CW_NRM;
        LAS float* tabw = (LAS float*)(lds + AL_TAB); LAS float* misc = (LAS float*)(lds + AL_MISC);
        if (wave == 0) {
            const float a = wave_sum(A.lq1[lane] * A.lk1[lane]), c = wave_sum(A.lq2[lane] * A.lk2[lane]);
            if (lane == 0) misc[4] = expf(a) - expf(c) + 0.2f;
        }
        for (int i = tid; i < 4 * 192; i += 512) { const int hh = i / 192, rel = (i % 192) - 128; tabw[i] = A.relb[t5_bucket(rel) * 4 + hh] * LOG2E; }
        __syncthreads();
        C.lam = misc[4];
#ifndef NO_K1
        attn_queue<1>(C, ctl + CW_Q0, 256, lds);
#endif
#ifndef NO_K3
        attn_queue<3>(C, ctl + CW_Q1, 128, lds);
#endif
#ifndef NO_K2
        attn_queue<2>(C, ctl + CW_Q2, 256, lds);
#endif
#ifndef NO_K0
        attn_queue<0>(C, ctl + CW_Q3, 512, lds);
#endif
    }
    xcd_barrier(bar);

    {
        pg8::Gemm g{(const pg8::bf16_t*)(A.ws + WS_H), (const pg8::bf16_t*)(A.ws + WS_WTOUT), MT, D, D};
        pg8::StaticOrder S; S.init(MT, D, G, bx);
        pg8::EpiOut E{(float*)(A.ws + WS_OUTF), (float*)(A.ws + WS_SS)};
        pg8::gemm_phase<pg8::EpiOut, pg8::StaticOrder, true, true>(lds, g, S, E);
    }
    xcd_barrier(bar);

    {
        const float* OUTF = (const float*)(A.ws + WS_OUTF); const float* SS = (const float*)(A.ws + WS_SS);
        const int gw = vcu * NWAVES + wave, NGW = G * NWAVES;
        f32x4 g[4];
#pragma unroll
        for (int j = 0; j < 4; ++j) g[j] = *(const f32x4*)(A.g_post + 4 * lane + 256 * j);
        for (int row = gw; row < MT; row += NGW) {
            const float sv = (lane < 16) ? SS[(size_t)row * 16 + lane] : 0.f;
            const float rstd = 1.0f / sqrtf(wave_sum(sv) * (1.0f / D) + EPSN);
            const float* xr = (row < NP) ? (A.x_p + (size_t)row * D) : (A.x_s + (size_t)(row - NP) * D);
            const float* orow = OUTF + (size_t)row * D; float* yr = A.out + (size_t)row * D;
#pragma unroll
            for (int j = 0; j < 4; ++j) { const f32x4 xv = *(const f32x4*)(xr + 4 * lane + 256 * j), ov = *(const f32x4*)(orow + 4 * lane + 256 * j);
                *(f32x4*)(yr + 4 * lane + 256 * j) = xv + ov * rstd * g[j]; }
        }
    }
}

extern "C" void kernel_launch(void* const* d_in, const int* in_sizes, int n_in, void* d_out, int out_size, void* d_ws, size_t ws_size, hipStream_t stream) {
    static int grid = 0;
    if (grid == 0) {
        if (n_in != 18 || in_sizes[0] != NP * D || (size_t)out_size != O_TOTAL || ws_size < WS_END) {
            fprintf(stderr, "kernel_launch: unexpected shapes: n_in %d in0 %d out %d ws %zu; nothing launched\n", n_in, n_in > 0 ? in_sizes[0] : -1, out_size, ws_size); grid = -1; return; }
        int dev = 0, cus = 0, per_cu = 0;
        if (hipGetDevice(&dev) != hipSuccess || hipDeviceGetAttribute(&cus, hipDeviceAttributeMultiprocessorCount, dev) != hipSuccess) { grid = -1; return; }
        if (hipFuncSetAttribute((const void*)fwd_kernel, hipFuncAttributeMaxDynamicSharedMemorySize, LDS_BYTES) != hipSuccess) { fprintf(stderr, "kernel_launch: hipFuncSetAttribute failed\n"); grid = -1; return; }
        if (hipOccupancyMaxActiveBlocksPerMultiprocessor(&per_cu, (const void*)fwd_kernel, NWAVES * 64, LDS_BYTES) != hipSuccess || per_cu < 1) {
            fprintf(stderr, "kernel_launch: occupancy query says %d blocks per CU; nothing launched\n", per_cu); (void)hipGetLastError(); grid = -1; return; }
        grid = cus;
    }
    if (grid < 0) return;
    (void)hipMemsetAsync((char*)d_ws + WS_CTL, 0, CTL_ZERO_BYTES, stream);
    Args a{};
    a.x_p = (const float*)d_in[0]; a.x_s = (const float*)d_in[1]; a.ck = (const float*)d_in[2]; a.cv = (const float*)d_in[3]; a.clf = (const float*)d_in[4];
    a.cdk = (const float*)d_in[5]; a.cdv = (const float*)d_in[6]; a.g_pre = (const float*)d_in[7]; a.w_in = (const float*)d_in[8]; a.b_f = (const float*)d_in[9];
    a.lq1 = (const float*)d_in[10]; a.lk1 = (const float*)d_in[11]; a.lq2 = (const float*)d_in[12]; a.lk2 = (const float*)d_in[13]; a.subln = (const float*)d_in[14];
    a.w_out = (const float*)d_in[15]; a.g_post = (const float*)d_in[16]; a.relb = (const float*)d_in[17];
    a.out = (float*)d_out; a.ws = (unsigned char*)d_ws;
    hipLaunchKernelGGL(fwd_kernel, dim3(grid), dim3(NWAVES * 64), LDS_BYTES, stream, a);
    const hipError_t le = hipPeekAtLastError();
    if (le != hipSuccess) fprintf(stderr, "kernel_launch: launch failed: %s\n", hipGetErrorName(le));
}
```

```cpp
#include <hip/hip_runtime.h>
#include <cstdio>
#include <cstdint>
#define GAS __attribute__((address_space(1)))
#define LAS __attribute__((address_space(3)))
namespace pg8 {
#define PG8_LAS __attribute__((address_space(3)))
typedef unsigned short bf16_t;
typedef short bf16x8 __attribute__((ext_vector_type(8)));
typedef float f32x4 __attribute__((ext_vector_type(4)));
typedef unsigned u32x4 __attribute__((ext_vector_type(4)));
constexpr int BM = 256, BK = 64, HALF = 128, HTB = HALF * BK * 2  , STAGE_BYTES = 8 * HTB, NXCD = 8, WGM = 8;

__host__ __device__ __forceinline__ int lds_byte(int r, int c) { const int st = (r >> 4) * 2 + (c >> 5), rr = r & 15, cc = c & 31, ob = rr * 64 + cc * 2; return st * 1024 + (ob ^ (((ob >> 9) & 1) << 5)); }
__host__ __device__ __forceinline__ void stage_rc(int b, int& R, int& C) { const int st = b / 1024, sb = b % 1024, swz = sb ^ (((sb >> 9) & 1) << 5); R = (st >> 1) * 16 + swz / 64; C = (st & 1) * 32 + (swz % 64) / 2; }
__host__ __device__ __forceinline__ int perm32(int rho) { const int n = rho >> 4, i = rho & 15; return 8 * (i >> 2) + 4 * n + (i & 3); }

struct Unit { int pm, pn; };
struct Gemm { const bf16_t* A; const bf16_t* Bt; int M, N, K; };

struct StaticOrder {
    int nM, nN, nwg, G, c;
    __host__ __device__ void init(int M, int N, int G_, int c_) { nM = M / BM; nN = N / BM; nwg = nM * nN; G = G_; c = c_; }
    __host__ __device__ bool next(int i, Unit& u) const {
        const long L = (long)i * G + c; if (L >= nwg) return false;
        int wgid = (int)L; { const int q = nwg / NXCD, r = nwg % NXCD, xcd = wgid % NXCD, off = wgid / NXCD; wgid = (xcd < r ? xcd * (q + 1) : r * (q + 1) + (xcd - r) * q) + off; }
        const int nig = WGM * nN, gid = wgid / nig, fm = gid * WGM, gsz = (nM - fm) < WGM ? (nM - fm) : WGM;
        u.pm = fm + ((wgid % nig) % gsz); u.pn = (wgid % nig) / gsz; return true;
    }
    __device__ __forceinline__ void a_ready(const Unit&) const {}
    __device__ __forceinline__ void done(const Unit&) const {}
};

__device__ __forceinline__ unsigned cvt_pk_bf16(float lo, float hi) { unsigned r; asm volatile("v_cvt_pk_bf16_f32 %0, %1, %2" : "=v"(r) : "v"(lo), "v"(hi)); return r; }
typedef float f32x2 __attribute__((ext_vector_type(2)));
typedef float f32x2 __attribute__((ext_vector_type(2)));
__device__ __forceinline__ float silu_f(float x) { return x * __builtin_amdgcn_rcpf(1.0f + __builtin_amdgcn_exp2f(-1.4426950408889634f * x)); }
struct EpiIn {
    static constexpr bool PERM = true, AFTER_DRAIN = false;
    bf16_t* segbase; size_t segstride;
    float* out;
    float c2; unsigned* nrm;
    __device__ __forceinline__ void norm_max(const f32x4 (&acc)[2][2][4][2], const Unit& u, int wc, float sc, int base) const {
        float mx[2] = {0.f, 0.f};
#pragma unroll
        for (int ai = 0; ai < 2; ++ai)
#pragma unroll
            for (int m = 0; m < 4; ++m)
#pragma unroll
                for (int bj = 0; bj < 2; ++bj) { const f32x4 a = acc[ai][bj][m][0] * sc, b = acc[ai][bj][m][1] * sc;
                    float s = (a[0] * a[0] + a[1] * a[1]) + (a[2] * a[2] + a[3] * a[3]) + (b[0] * b[0] + b[1] * b[1]) + (b[2] * b[2] + b[3] * b[3]);
                    s += __shfl_xor(s, 16); s += __shfl_xor(s, 32); mx[bj] = fmaxf(mx[bj], s); }
#pragma unroll
        for (int bj = 0; bj < 2; ++bj) {
#pragma unroll
            for (int o = 1; o < 16; o <<= 1) mx[bj] = fmaxf(mx[bj], __shfl_xor(mx[bj], o));
            if ((threadIdx.x & 63) == 0) { const int head = (u.pn & 1) * 4 + bj * 2 + (wc >> 1); atomicMax(nrm + base + head * 2 + (wc & 1), __float_as_uint(mx[bj])); } }
    }
    __device__ __forceinline__ void operator()(const f32x4 (&acc)[2][2][4][2], const Unit& u, int wr, int wc, int fr, int fq) const {
        const int seg = u.pn >> 1;
        const int col0 = (u.pn & 1) * 256 + wc * 32 + 8 * fq;
        const int row0 = u.pm * BM + wr * 64 + fr;
        bf16_t* bb = segbase + (size_t)seg * segstride;
        const bool is_s = (u.pm >= 64);
        const int mode = (seg == 0 || seg == 4) ? 0 : ((seg == 3 || seg == 7) ? 2 : 1);
        if (seg == 0) norm_max(acc, u, wc, c2, 0);
        if (seg == 1) norm_max(acc, u, wc, 1.0f, 16);
        if (mode == 1) {
            const size_t offp = seg == 1 ? (size_t)18874368 : seg == 2 ? (size_t)27262976 : seg == 5 ? (size_t)35782656 : (size_t)44171264;
            const size_t offs = seg == 1 ? (size_t)52559872 : seg == 2 ? (size_t)53608448 : seg == 5 ? (size_t)54673408 : (size_t)55721984;
            float* fb = out + (is_s ? offs : offp);
            const int rsub = is_s ? 16384 : 0;
#pragma unroll
            for (int ai = 0; ai < 2; ++ai)
#pragma unroll
                for (int m = 0; m < 4; ++m) { const int row = row0 + ai * HALF + m * 16;
                    bf16_t* rowp = bb + (size_t)row * 512 + col0; float* frow = fb + (size_t)(row - rsub) * 512 + col0;
#pragma unroll
                    for (int bj = 0; bj < 2; ++bj) { const f32x4 v0 = acc[ai][bj][m][0], v1 = acc[ai][bj][m][1];
                        *(f32x4*)(frow + bj * HALF) = v0; *(f32x4*)(frow + bj * HALF + 4) = v1;
                        u32x4 w; w.x = cvt_pk_bf16(v0[0], v0[1]); w.y = cvt_pk_bf16(v0[2], v0[3]); w.z = cvt_pk_bf16(v1[0], v1[1]); w.w = cvt_pk_bf16(v1[2], v1[3]);
                        *(u32x4*)(rowp + bj * HALF) = w; } }
        } else if (mode == 0) {
            const float sc = c2;
#pragma unroll
            for (int ai = 0; ai < 2; ++ai)
#pragma unroll
                for (int m = 0; m < 4; ++m) { const int row = row0 + ai * HALF + m * 16; bf16_t* rowp = bb + (size_t)row * 512 + col0;
#pragma unroll
                    for (int bj = 0; bj < 2; ++bj) { const f32x4 v0 = acc[ai][bj][m][0] * sc, v1 = acc[ai][bj][m][1] * sc;
                        u32x4 w; w.x = cvt_pk_bf16(v0[0], v0[1]); w.y = cvt_pk_bf16(v0[2], v0[3]); w.z = cvt_pk_bf16(v1[0], v1[1]); w.w = cvt_pk_bf16(v1[2], v1[3]);
                        *(u32x4*)(rowp + bj * HALF) = w; } }
        } else {
#pragma unroll
            for (int ai = 0; ai < 2; ++ai)
#pragma unroll
                for (int m = 0; m < 4; ++m) { const int row = row0 + ai * HALF + m * 16; bf16_t* rowp = bb + (size_t)row * 512 + col0;
#pragma unroll
                    for (int bj = 0; bj < 2; ++bj) { const f32x4 a0 = acc[ai][bj][m][0], a1 = acc[ai][bj][m][1];
                        u32x4 w; w.x = cvt_pk_bf16(silu_f(a0[0]), silu_f(a0[1])); w.y = cvt_pk_bf16(silu_f(a0[2]), silu_f(a0[3]));
                        w.z = cvt_pk_bf16(silu_f(a1[0]), silu_f(a1[1])); w.w = cvt_pk_bf16(silu_f(a1[2]), silu_f(a1[3]));
                        *(u32x4*)(rowp + bj * HALF) = w; } }
        }
    }
};
struct EpiOut {
    static constexpr bool PERM = false, AFTER_DRAIN = false;
    float* outf; float* ss;
    __device__ __forceinline__ void operator()(const f32x4 (&acc)[2][2][4][2], const Unit& u, int wr, int wc, int fr, int fq) const {
        const int col0 = u.pn * BM + wc * 32 + 4 * fq;
#pragma unroll
        for (int ai = 0; ai < 2; ++ai)
#pragma unroll
            for (int m = 0; m < 4; ++m) { const int row = u.pm * BM + ai * HALF + wr * 64 + m * 16 + fr; float* rp = outf + (size_t)row * 1024 + col0; float s = 0.f;
#pragma unroll
                for (int bj = 0; bj < 2; ++bj)
#pragma unroll
                    for (int n = 0; n < 2; ++n) { const f32x4 v = acc[ai][bj][m][n]; *(f32x4*)(rp + bj * HALF + n * 16) = v; s += (v[0] * v[0] + v[1] * v[1]) + (v[2] * v[2] + v[3] * v[3]); }
                s += __shfl_xor(s, 16); s += __shfl_xor(s, 32);
                if (fq == 0) ss[(size_t)row * 16 + u.pn * 4 + wc] = s; }
    }
};
template <class Epi, class Sched, bool ALIGN_EPI = false, bool SP2 = false>
__device__ __forceinline__ void gemm_phase(PG8_LAS unsigned char* lds, const Gemm g, const Sched& S, const Epi& E) {
    const int tid = threadIdx.x, wid = __builtin_amdgcn_readfirstlane(tid >> 6), lane = tid & 63, wr = wid >> 2, wc = wid & 3, fr = lane & 15, fq = lane >> 4;
    const int K = g.K, nt = K / BK;
    unsigned voffA[2], voffB[2];
#pragma unroll
    for (int i = 0; i < 2; ++i) { int R, C; stage_rc(tid * 16 + i * 8192, R, C); const int Rb = Epi::PERM ? ((R & ~31) + perm32(R & 31)) : R;
        voffA[i] = (unsigned)(R * K + C) * 2u; voffB[i] = (unsigned)(Rb * K + C) * 2u; }
    const size_t kstep = (size_t)(BK * 2);
    const size_t hstep = (size_t)HALF * K * 2;
    const size_t tstep = 2 * hstep;
    const unsigned ldsw = (unsigned)wid * 1024u;
    const int aoff = lds_byte(wr * 64 + fr, fq * 8), boff = lds_byte(wc * 32 + fr, fq * 8);
#define PG8_SA(b, h) (((b) * 2 + (h)) * HTB)
#define PG8_SB(b, h) ((4 + (b) * 2 + (h)) * HTB)
#define PG8_STAGE(bufoff, gbase, voff) do { _Pragma("unroll") for (int _i = 0; _i < 2; ++_i) \
        __builtin_amdgcn_global_load_lds((const unsigned*)((const char*)(gbase) + (voff)[_i]), (PG8_LAS unsigned*)(lds + (bufoff) + ldsw + _i * 8192), 16, 0, 0); } while (0)
#define PG8_LDA(dst, b, h) do { _Pragma("unroll") for (int m = 0; m < 4; ++m) _Pragma("unroll") for (int k = 0; k < 2; ++k) dst[m][k] = *(const PG8_LAS bf16x8*)(lds + PG8_SA(b, h) + aoff + m * 2048 + k * 1024); } while (0)
#define PG8_LDB(dst, b, h) do { _Pragma("unroll") for (int n = 0; n < 2; ++n) _Pragma("unroll") for (int k = 0; k < 2; ++k) dst[n][k] = *(const PG8_LAS bf16x8*)(lds + PG8_SB(b, h) + boff + n * 2048 + k * 1024); } while (0)
#define PG8_MMA(ai, bj, At, Bt) do { __builtin_amdgcn_s_setprio(1); _Pragma("unroll") for (int m = 0; m < 4; ++m) _Pragma("unroll") for (int n = 0; n < 2; ++n) _Pragma("unroll") for (int k = 0; k < 2; ++k) \
        acc[ai][bj][m][n] = __builtin_amdgcn_mfma_f32_16x16x32_bf16(Bt[n][k], At[m][k], acc[ai][bj][m][n], 0, 0, 0); __builtin_amdgcn_s_setprio(0); } while (0)
#define PG8_WAIT_V(n) asm volatile("s_waitcnt vmcnt(" #n ")" ::: "memory")
#define PG8_WAIT_L(n) asm volatile("s_waitcnt lgkmcnt(" #n ")" ::: "memory")
#define PG8_BAR __builtin_amdgcn_s_barrier()
#define PG8_SCHED __builtin_amdgcn_sched_barrier(0)
    Unit cur, nxt; int ui = 0;
    if (!S.next(0, cur)) return;
    f32x4 acc[2][2][4][2];
#pragma unroll
    for (int a = 0; a < 2; ++a)
#pragma unroll
        for (int b = 0; b < 2; ++b)
#pragma unroll
            for (int m = 0; m < 4; ++m)
#pragma unroll
                for (int n = 0; n < 2; ++n) acc[a][b][m][n] = (f32x4){0.f, 0.f, 0.f, 0.f};
    bf16x8 At[4][2], B0[2][2], B1[2][2];
    const char* cA = (const char*)g.A + (size_t)cur.pm * tstep; const char* cB = (const char*)g.Bt + (size_t)cur.pn * tstep;
    S.a_ready(cur);
    if constexpr (SP2) {
        PG8_STAGE(PG8_SB(0, 0), cB, voffB); PG8_STAGE(PG8_SB(0, 1), cB + hstep, voffB); PG8_STAGE(PG8_SA(0, 0), cA, voffA); PG8_STAGE(PG8_SA(0, 1), cA + hstep, voffA);
        if (wr == 1) PG8_BAR;
        PG8_WAIT_V(2); PG8_BAR;
        PG8_STAGE(PG8_SB(1, 0), cB + kstep, voffB); PG8_STAGE(PG8_SA(1, 0), cA + kstep, voffA); PG8_STAGE(PG8_SB(1, 1), cB + hstep + kstep, voffB);
        PG8_WAIT_V(6); PG8_BAR;
    } else {
        PG8_STAGE(PG8_SB(0, 0), cB, voffB); PG8_STAGE(PG8_SA(0, 0), cA, voffA); PG8_STAGE(PG8_SB(0, 1), cB + hstep, voffB); PG8_STAGE(PG8_SA(0, 1), cA + hstep, voffA);
        if (wr == 1) PG8_BAR;
        PG8_WAIT_V(4); PG8_BAR;
        PG8_STAGE(PG8_SB(1, 0), cB + kstep, voffB); PG8_STAGE(PG8_SA(1, 0), cA + kstep, voffA); PG8_STAGE(PG8_SB(1, 1), cB + hstep + kstep, voffB);
        PG8_WAIT_V(6); PG8_BAR;
    }
    for (;;) {
        const bool has_next = S.next(ui + 1, nxt);
        const char* nA = has_next ? (const char*)g.A + (size_t)nxt.pm * tstep : cA; const char* nB = has_next ? (const char*)g.Bt + (size_t)nxt.pn * tstep : cB;
        for (int t = 0; t < nt; t += 2) {
            const bool last = (t == nt - 2);
            const char* a1 = cA + (size_t)(t + 1) * kstep;
            const char* a2 = last ? nA : cA + (size_t)(t + 2) * kstep; const char* b2 = last ? nB : cB + (size_t)(t + 2) * kstep;
            const char* a3 = a2 + kstep; const char* b3 = b2 + kstep;
            if (last && has_next) S.a_ready(nxt);
            if constexpr (SP2) {
            PG8_LDB(B0, 0, 0); PG8_LDB(B1, 0, 1); PG8_SCHED; PG8_LDA(At, 0, 0); PG8_STAGE(PG8_SA(1, 1), a1 + hstep, voffA);
            PG8_WAIT_V(8); PG8_WAIT_L(0); PG8_BAR; PG8_MMA(0, 0, At, B0); PG8_MMA(0, 1, At, B1); PG8_BAR; PG8_SCHED;
            PG8_LDA(At, 0, 1); PG8_STAGE(PG8_SB(0, 0), b2, voffB); PG8_STAGE(PG8_SB(0, 1), b2 + hstep, voffB); PG8_STAGE(PG8_SA(0, 0), a2, voffA);
            PG8_WAIT_V(8); PG8_WAIT_L(0); PG8_BAR; PG8_MMA(1, 0, At, B0); PG8_MMA(1, 1, At, B1); PG8_BAR; PG8_SCHED;
            PG8_LDB(B0, 1, 0); PG8_LDB(B1, 1, 1); PG8_SCHED; PG8_LDA(At, 1, 0); PG8_STAGE(PG8_SA(0, 1), a2 + hstep, voffA);
            PG8_WAIT_V(8); PG8_WAIT_L(0); PG8_BAR; PG8_MMA(0, 0, At, B0); PG8_MMA(0, 1, At, B1); PG8_BAR; PG8_SCHED;
            PG8_LDA(At, 1, 1); PG8_STAGE(PG8_SB(1, 0), b3, voffB); PG8_STAGE(PG8_SB(1, 1), b3 + hstep, voffB); PG8_STAGE(PG8_SA(1, 0), a3, voffA);
            PG8_WAIT_V(8); PG8_WAIT_L(0); PG8_BAR; PG8_MMA(1, 0, At, B0); PG8_MMA(1, 1, At, B1); PG8_BAR; PG8_SCHED;
            } else {
            PG8_LDB(B0, 0, 0); PG8_SCHED; PG8_LDA(At, 0, 0); PG8_STAGE(PG8_SA(1, 1), a1 + hstep, voffA);
            PG8_WAIT_L(8); PG8_BAR; PG8_WAIT_L(0); PG8_MMA(0, 0, At, B0); PG8_BAR; PG8_SCHED;
            PG8_LDB(B1, 0, 1); PG8_STAGE(PG8_SB(0, 0), b2, voffB);
            PG8_BAR; PG8_WAIT_L(0); PG8_MMA(0, 1, At, B1); PG8_BAR;
            PG8_LDA(At, 0, 1); PG8_STAGE(PG8_SA(0, 0), a2, voffA);
            PG8_BAR; PG8_WAIT_L(0); PG8_MMA(1, 0, At, B0); PG8_BAR; PG8_SCHED;
            PG8_STAGE(PG8_SB(0, 1), b2 + hstep, voffB);
            PG8_WAIT_V(6); PG8_BAR; PG8_MMA(1, 1, At, B1); PG8_BAR;
            PG8_LDB(B0, 1, 0); PG8_SCHED; PG8_LDA(At, 1, 0); PG8_STAGE(PG8_SA(0, 1), a2 + hstep, voffA);
            PG8_WAIT_L(8); PG8_BAR; PG8_WAIT_L(0); PG8_MMA(0, 0, At, B0); PG8_BAR; PG8_SCHED;
            PG8_LDB(B1, 1, 1); PG8_STAGE(PG8_SB(1, 0), b3, voffB);
            PG8_BAR; PG8_WAIT_L(0); PG8_MMA(0, 1, At, B1); PG8_BAR;
            PG8_LDA(At, 1, 1); PG8_STAGE(PG8_SA(1, 0), a3, voffA);
            PG8_BAR; PG8_WAIT_L(0); PG8_MMA(1, 0, At, B0); PG8_BAR; PG8_SCHED;
            PG8_STAGE(PG8_SB(1, 1), b3 + hstep, voffB);
            PG8_WAIT_V(6); PG8_BAR; PG8_MMA(1, 1, At, B1); PG8_BAR;
            }
        }
        if constexpr (ALIGN_EPI) { if (wr == 0) PG8_BAR; }
        if constexpr (!Epi::AFTER_DRAIN) { E(acc, cur, wr, wc, fr, fq); S.done(cur); }
        if (!has_next) break;
#pragma unroll
        for (int a = 0; a < 2; ++a)
#pragma unroll
            for (int b = 0; b < 2; ++b)
#pragma unroll
                for (int m = 0; m < 4; ++m)
#pragma unroll
                    for (int n = 0; n < 2; ++n) acc[a][b][m][n] = (f32x4){0.f, 0.f, 0.f, 0.f};
        cur = nxt; cA = nA; cB = nB; ++ui;
        if constexpr (ALIGN_EPI) { if (wr == 1) PG8_BAR; }
    }
    PG8_WAIT_V(0);
    if constexpr (!ALIGN_EPI) { if (wr == 0) PG8_BAR; }
    PG8_BAR;
    if constexpr (Epi::AFTER_DRAIN) { E.fused(acc, cur, wr, wc, fr, fq, lds, wid, lane); S.done(cur); }
#undef PG8_SA
#undef PG8_SB
#undef PG8_STAGE
#undef PG8_LDA
#undef PG8_LDB
#undef PG8_MMA
#undef PG8_WAIT_V
#undef PG8_WAIT_L
#undef PG8_BAR
#undef PG8_SCHED
}
}
#define XB_TMO      128
#define XB_XCNT(j)  (256  + 64 * (j))
#define XB_XSUB(j)  (1280 + 64 * (j))
#define XB_XGEN(j)  (2304 + 64 * (j))
#define XB_TOP      3328
#define XB_TOPGEN   3392
#define XCD_BAR_WORDS 3456
#define XB_SPIN_CAP (1u << 18)

__device__ __forceinline__ unsigned xb_ld(unsigned* p)              { return __hip_atomic_load(p, __ATOMIC_RELAXED, __HIP_MEMORY_SCOPE_AGENT); }
__device__ __forceinline__ unsigned xb_add(unsigned* p, unsigned v) { return __hip_atomic_fetch_add(p, v, __ATOMIC_RELAXED, __HIP_MEMORY_SCOPE_AGENT); }
__device__ __forceinline__ unsigned xb_xcc_id() { return (unsigned)__builtin_amdgcn_s_getreg((3 << 11) | 20) & 0xFu; }
#define XB_SPIN(cond, bar) do { unsigned _sp = 0; while (cond) { __builtin_amdgcn_s_sleep(1); \
    if ((++_sp & 255u) == 0u) { if (xb_ld(&(bar)[XB_TMO])) break; if (_sp > XB_SPIN_CAP) { atomicAdd(&(bar)[XB_TMO], 1u); break; } } } } while (0)

struct XcdBarrier {
    unsigned* bar; unsigned x;
    volatile LAS unsigned* st;
};

__device__ __forceinline__ XcdBarrier xcd_barrier_post(unsigned* bar, volatile LAS unsigned* st) {
    XcdBarrier b; b.bar = bar; b.x = xb_xcc_id(); b.st = st;
    if (threadIdx.x == 0) (void)xb_add(&bar[XB_XCNT(b.x)], 1u);
    return b;
}
__device__ __forceinline__ void xcd_barrier_complete(unsigned* bar, unsigned x, unsigned& nloc, unsigned& nx) {
    const unsigned G = gridDim.x * gridDim.y * gridDim.z;
    unsigned sum, cnt, mine, sp = 0u;
    for (;;) {
        sum = 0u; cnt = 0u; mine = 0u;
#pragma unroll
        for (unsigned j = 0; j < 16; ++j) { const unsigned c = xb_ld(&bar[XB_XCNT(j)]); sum += c; cnt += (c > 0u) ? 1u : 0u; mine = (j == x) ? c : mine; }
        if (sum == G) break;
        __builtin_amdgcn_s_sleep(1);
        if ((++sp & 255u) == 0u) { if (xb_ld(&bar[XB_TMO])) break; if (sp > XB_SPIN_CAP) { atomicAdd(&bar[XB_TMO], 1u); break; } }
    }
    nloc = mine > 0u ? mine : 1u; nx = cnt > 0u ? cnt : 1u;
}

__device__ __forceinline__ void xcd_barrier(const XcdBarrier& b) {
    asm volatile("s_waitcnt vmcnt(0)" ::: "memory");
    __syncthreads();
    if (threadIdx.x == 0) {
        unsigned* bar = b.bar;
        __builtin_amdgcn_s_waitcnt(0);
        unsigned nloc = b.st[0], nx = b.st[1];
        if (nloc == 0u) { xcd_barrier_complete(bar, b.x, nloc, nx); b.st[0] = nloc; b.st[1] = nx; }
        const unsigned old = xb_add(&bar[XB_XSUB(b.x)], 1u);
        const unsigned gen = old / nloc;
        if (old + 1u == (gen + 1u) * nloc) {
            __builtin_amdgcn_fence(__ATOMIC_RELEASE, "agent");
            asm volatile("s_waitcnt vmcnt(0)" ::: "memory");
            const unsigned og = xb_add(&bar[XB_TOP], 1u);
            const unsigned tg = og / nx;
            if (og + 1u == (tg + 1u) * nx) xb_add(&bar[XB_TOPGEN], 1u);
            else XB_SPIN(xb_ld(&bar[XB_TOPGEN]) == tg, bar);
            __builtin_amdgcn_fence(__ATOMIC_ACQUIRE, "agent");
            xb_add(&bar[XB_XGEN(b.x)], 1u);
            asm volatile("s_waitcnt vmcnt(0)" ::: "memory");
        } else {
            XB_SPIN(xb_ld(&bar[XB_XGEN(b.x)]) == gen, bar);
            __builtin_amdgcn_fence(__ATOMIC_ACQUIRE, "agent");
            asm volatile("s_waitcnt vmcnt(0)" ::: "memory");
        }
    }
    __syncthreads();
}

constexpr int NWAVES = 8;
#ifndef LBW
#define LBW 2
#endif
constexpr int D = 1024, NP = 16384, NS = 2048, MT = NP + NS;
constexpr int PAST = 4096, NB = 32;
constexpr int WIN_LD = 4104;
constexpr float EPSN = 1e-6f;
constexpr float LOG2E = 1.4426950408889634f;
constexpr float C2 = 0.125f * LOG2E;
constexpr float NEGBIG = -1e30f;
constexpr float SKIP_THR = 48.0f;
constexpr float RESC_THR = 8.0f;
constexpr size_t O_FKP = 18874368, O_FVP = 27262976, O_LFP = 35651584, O_DKP = 35782656, O_DVP = 44171264, O_FKS = 52559872, O_FVS = 53608448, O_LFS = 54657024, O_DKS = 54673408, O_DVS = 55721984, O_TOTAL = 56770560;
constexpr size_t MiB = 1u << 20;
constexpr size_t WS_CTL = 0, CTL_ZERO_BYTES = 65536;
constexpr size_t WS_WTIN = 2 * MiB, WS_WTOUT = 10 * MiB, WS_LCUM = 12 * MiB, WS_TTOT = 13 * MiB, WS_LC = 14 * MiB, WS_TC = 18 * MiB, WS_SS = 19 * MiB;
constexpr size_t WS_H = 32 * MiB;
constexpr size_t WS_SEG = 68 * MiB, SEG_BYTES = 18 * MiB;
constexpr size_t WS_STASH = 316 * MiB;
constexpr size_t WS_OUTF = 244 * MiB;
constexpr size_t WS_END = 380 * MiB;
constexpr int CW_BAR = 4096;
constexpr int CW_Q0 = 64, CW_Q1 = 128, CW_Q2 = 192, CW_Q3 = 256;
constexpr int CW_FLAGS = 8192;
constexpr int CW_NRM = 512;
constexpr int RING_BYTES = 131072;
constexpr int MISC_OFF = RING_BYTES;
constexpr int LDS_BYTES = 147456;

typedef unsigned short bf16;
typedef unsigned v4u __attribute__((ext_vector_type(4)));
typedef float f32x4 __attribute__((ext_vector_type(4)));
typedef float f32x16 __attribute__((ext_vector_type(16)));
typedef short bf16x8 __attribute__((ext_vector_type(8)));
typedef short s16x4 __attribute__((ext_vector_type(4)));
typedef short v4i16_t __attribute__((ext_vector_type(4)));
#define LDS_WAIT() asm volatile("s_waitcnt lgkmcnt(0)" ::: "memory")

__device__ __forceinline__ unsigned f2bf(float f) { unsigned u = __builtin_bit_cast(unsigned, f); return (u + 0x7fffu + ((u >> 16) & 1u)) >> 16; }
typedef float f32x2_t __attribute__((ext_vector_type(2))); typedef __bf16 bf16x2_t __attribute__((ext_vector_type(2)));
__device__ __forceinline__ unsigned pk2(float lo, float hi) { f32x2_t v = {lo, hi}; bf16x2_t b = __builtin_convertvector(v, bf16x2_t); return __builtin_bit_cast(unsigned, b); }
__device__ __forceinline__ float bf2f(unsigned short b) { return __builtin_bit_cast(float, (unsigned)b << 16); }
__device__ __forceinline__ float wave_sum(float v) {
#pragma unroll
    for (int o = 1; o < 64; o <<= 1) v += __shfl_xor(v, o);
    return v;
}
__device__ __forceinline__ unsigned ldu(const unsigned* p) { return __hip_atomic_load(p, __ATOMIC_RELAXED, __HIP_MEMORY_SCOPE_AGENT); }
__device__ __forceinline__ int crow(int r, int hi) { return (r & 3) + 8 * (r >> 2) + 4 * hi; }

struct Args {
    const float* x_p; const float* x_s; const float* ck; const float* cv; const float* clf; const float* cdk; const float* cdv;
    const float* g_pre; const float* w_in; const float* b_f; const float* lq1; const float* lk1; const float* lq2; const float* lk2;
    const float* subln; const float* w_out; const float* g_post; const float* relb;
    float* out; unsigned char* ws;
};

__device__ __forceinline__ void p0_transpose_item(const float* W, int ldw, int K, int nblk, int split, int skip, bf16* WT, LAS float* scr, int item, int lane) {
    const int kb = item / nblk, nb = item % nblk, k0 = 64 * kb, n0 = 32 * nb, w0 = n0 + (n0 >= split ? skip : 0);
#pragma unroll 8
    for (int i = 0; i < 32; ++i) { const int kk = 2 * i + (lane >> 5); scr[kk * 33 + (lane & 31)] = W[(size_t)(k0 + kk) * ldw + w0 + (lane & 31)]; }
    LDS_WAIT(); asm volatile("" ::: "memory");
    const int c = lane & 7;
#pragma unroll
    for (int j = 0; j < 4; ++j) { const int n = (lane >> 3) + 8 * j; const LAS float* s = scr + (8 * c) * 33 + n;
        v4u o; o.x = pk2(s[0 * 33], s[1 * 33]); o.y = pk2(s[2 * 33], s[3 * 33]); o.z = pk2(s[4 * 33], s[5 * 33]); o.w = pk2(s[6 * 33], s[7 * 33]);
        *(v4u*)(WT + (size_t)(n0 + n) * K + k0 + 8 * c) = o; }
    LDS_WAIT(); asm volatile("" ::: "memory");
}

__device__ __forceinline__ void p0_prologue(const Args& A, LAS unsigned char* lds, int vcu, int G) {
    const int tid = threadIdx.x, lane = tid & 63, wave = __builtin_amdgcn_readfirstlane(tid >> 6);
    const int gw = vcu * NWAVES + wave, NGW = G * NWAVES;
    {
        LAS float* scr = (LAS float*)(lds + wave * 16384);
        bf16* WTin = (bf16*)(A.ws + WS_WTIN); bf16* WTout = (bf16*)(A.ws + WS_WTOUT);
        constexpr int I_IN = (D / 64) * (4096 / 32), I_OUT = (D / 64) * (D / 32);
        for (int it = gw; it < I_IN + I_OUT; it += NGW) {
            if (it < I_IN) p0_transpose_item(A.w_in, WIN_LD, D, 4096 / 32, 1536, 8, WTin, scr, it, lane);
            else p0_transpose_item(A.w_out, D, D, D / 32, 1 << 30, 0, WTout, scr, it - I_IN, lane);
        }
    }
    {
        float* LC = (float*)(A.ws + WS_LC); float* TC = (float*)(A.ws + WS_TC);
        for (int ch = gw; ch < NB * 64; ch += NGW) {
            const float* src = A.clf + (size_t)ch * 512 + lane * 8;
            f32x4 a = *(const f32x4*)src, b = *(const f32x4*)(src + 4);
            float v[8] = {a[0], a[1], a[2], a[3], b[0], b[1], b[2], b[3]};
#pragma unroll
            for (int o = 1; o < 64; o <<= 1) {
#pragma unroll
                for (int j = 0; j < 8; ++j) { const float t = __shfl_up(v[j], o); if (lane >= o) v[j] += t; }
            }
            float* dst = LC + (size_t)ch * 512 + lane * 8;
            *(f32x4*)dst = (f32x4){v[0], v[1], v[2], v[3]}; *(f32x4*)(dst + 4) = (f32x4){v[4], v[5], v[6], v[7]};
            if (lane == 63) { float* t = TC + (size_t)ch * 8; *(f32x4*)t = (f32x4){v[0], v[1], v[2], v[3]}; *(f32x4*)(t + 4) = (f32x4){v[4], v[5], v[6], v[7]}; }
        }
    }
    __syncthreads();
    {
        LAS float* wff = (LAS float*)lds;
        LAS float* lfb = (LAS float*)(lds + 32768);
        for (int i = tid; i < 1024 * 8; i += 512) wff[i] = A.w_in[(size_t)(i >> 3) * WIN_LD + 1536 + (i & 7)];
        __syncthreads();
        bf16* H = (bf16*)(A.ws + WS_H); float* LCUM = (float*)(A.ws + WS_LCUM); float* TTOT = (float*)(A.ws + WS_TTOT);
        f32x4 g[4];
#pragma unroll
        for (int j = 0; j < 4; ++j) g[j] = *(const f32x4*)(A.g_pre + 4 * lane + 256 * j);
        const float bfv = A.b_f[lane & 7];
        for (int blk = vcu; blk < MT / 64; blk += G) {
            for (int i = 0; i < 8; ++i) {
                const int rl = wave * 8 + i, row = blk * 64 + rl;
                const float* xr = (row < NP) ? (A.x_p + (size_t)row * D) : (A.x_s + (size_t)(row - NP) * D);
                f32x4 v[4]; float s = 0.f;
#pragma unroll
                for (int j = 0; j < 4; ++j) { v[j] = *(const f32x4*)(xr + 4 * lane + 256 * j); s += (v[j][0] * v[j][0] + v[j][1] * v[j][1]) + (v[j][2] * v[j][2] + v[j][3] * v[j][3]); }
                const float rstd = 1.0f / sqrtf(wave_sum(s) * (1.0f / D) + EPSN);
                float ff[8] = {0.f, 0.f, 0.f, 0.f, 0.f, 0.f, 0.f, 0.f};
                unsigned long long* o8 = (unsigned long long*)(H + (size_t)row * D) + lane;
#pragma unroll
                for (int j = 0; j < 4; ++j) {
                    const f32x4 hv = v[j] * rstd * g[j];
                    o8[64 * j] = (unsigned long long)pk2(hv[0], hv[1]) | ((unsigned long long)pk2(hv[2], hv[3]) << 32);
#pragma unroll
                    for (int e = 0; e < 4; ++e) { const LAS float* wr = wff + (size_t)(256 * j + 4 * lane + e) * 8; const f32x4 w0 = *(const LAS f32x4*)wr, w1 = *(const LAS f32x4*)(wr + 4);
                        ff[0] += hv[e] * w0[0]; ff[1] += hv[e] * w0[1]; ff[2] += hv[e] * w0[2]; ff[3] += hv[e] * w0[3];
                        ff[4] += hv[e] * w1[0]; ff[5] += hv[e] * w1[1]; ff[6] += hv[e] * w1[2]; ff[7] += hv[e] * w1[3]; }
                }
                float z = 0.f;
#pragma unroll
                for (int j = 0; j < 8; ++j) { const float t = wave_sum(ff[j]); z = ((lane & 7) == j) ? t : z; }
                z += bfv;
                const float lf = fminf(z, 0.f) - log1pf(expf(-fabsf(z)));
                if (lane < 8) { lfb[rl * 8 + lane] = lf;
                    if (row < NP) A.out[O_LFP + (size_t)row * 8 + lane] = lf; else A.out[O_LFS + (size_t)(row - NP) * 8 + lane] = lf; }
            }
            __syncthreads();
            if (tid < 8) { float run = 0.f;
                for (int r = 0; r < 64; ++r) { run += lfb[r * 8 + tid]; LCUM[(size_t)(blk * 64 + r) * 8 + tid] = run; }
                TTOT[blk * 8 + tid] = run; }
            __syncthreads();
        }
    }
}

constexpr int AL_K = 0, AL_V = 16384, AL_STG = 0, AL_CK = 65536, AL_WSF = 66048, AL_TOT = 68096, AL_DD = 69184, AL_TAB = 70272, AL_MISC = 73344;

__device__ __forceinline__ s16x4 vtr(const LAS unsigned char* p) { return __builtin_bit_cast(s16x4, __builtin_amdgcn_ds_read_tr16_b64_v4i16((LAS v4i16_t*)p)); }
__device__ __forceinline__ bf16x8 cvt8(const f32x4 a, const f32x4 b) {
    v4u w; w.x = pk2(a[0], a[1]); w.y = pk2(a[2], a[3]); w.z = pk2(b[0], b[1]); w.w = pk2(b[2], b[3]); return __builtin_bit_cast(bf16x8, w); }

struct AttnCtx {
    const bf16 *QF, *KF, *VF, *GF, *DQ, *DK, *DV, *GD; bf16* MIX;
    const float *LCUM, *TTOT, *LC, *TC;
    const float *ck, *cv, *cdk, *cdv;
    const float* subln; float lam; float* stash; const unsigned* nrm; unsigned* flags;
};

template <int KIND>
__device__ __forceinline__ void attn_unit(const AttnCtx& C, int u, LAS unsigned char* lds) {
    constexpr bool FOX = (KIND == 0 || KIND == 2), SAMPLE = (KIND >= 2);
    constexpr int DV = FOX ? 64 : 128, NDB = DV / 32, NMAP = FOX ? 1 : 2, NVC = DV / 64;
    int tid = threadIdx.x; asm volatile("" : "+v"(tid));
    const int lane = tid & 63, r32 = lane & 31, hi = lane >> 5; const int wid = __builtin_amdgcn_readfirstlane(tid >> 6);
    int h, qb = 0, b = 0, NT, qrow, qpos, tref, umap = 0;
    if (KIND == 0) { h = u & 7; qb = 63 - (u >> 3); }
    else if (KIND == 1) { umap = u >> 8; h = u & 3; qb = 63 - ((u & 255) >> 2); }
    else if (KIND == 2) { h = u & 7; b = u >> 3; }
    else { h = u & 3; b = u >> 2; }
    if (!SAMPLE) { NT = 4 * qb + 4; qrow = 256 * qb + 32 * wid + r32; qpos = qrow; tref = 4 * qb; }
    else { NT = 65; qrow = NP + b * 64 + 32 * (wid & 1) + r32; qpos = PAST + 32 * (wid & 1) + r32; tref = 64; }
    const bool compute_wave = SAMPLE ? (wid < 2) : true;
    LAS float* ckt = (LAS float*)(lds + AL_CK); LAS float* wsf = (LAS float*)(lds + AL_WSF) + wid * 64;
    LAS float* tot = (LAS float*)(lds + AL_TOT); LAS float* dd = (LAS float*)(lds + AL_DD); const LAS float* tab = (const LAS float*)(lds + AL_TAB) + h * 192;
    float cq = 0.f;
    if (FOX) {
        __syncthreads();
        for (int c = tid; c < NT; c += 512) { float t;
            if (!SAMPLE) t = C.TTOT[c * 8 + h]; else t = (c < 64) ? C.TC[(size_t)(b * 64 + c) * 8 + h] : C.TTOT[(256 + b) * 8 + h];
            tot[c] = t; }
        __syncthreads();
        if (wid == 0) {
            float loc[4]; float run = 0.f;
#pragma unroll
            for (int j = 0; j < 4; ++j) { const int c = tref - 1 - (4 * lane + j); const float v = (c >= 0) ? tot[c] : 0.f; run += v; loc[j] = run; }
            float incl = run;
#pragma unroll
            for (int o = 1; o < 64; o <<= 1) { const float t = __shfl_up(incl, o); if (lane >= o) incl += t; }
            const float excl = incl - run;
#pragma unroll
            for (int j = 0; j < 4; ++j) { const int c = tref - 1 - (4 * lane + j); if (c >= 0) dd[c] = -(excl + loc[j]); }
            if (lane == 0) { float s = 0.f; dd[tref] = 0.f; for (int c = tref + 1; c < NT; ++c) { s += tot[c - 1]; dd[c] = s; } }
            if (KIND == 0) {
                const float qn2 = __uint_as_float(ldu(C.nrm + h * 2)) + __uint_as_float(ldu(C.nrm + h * 2 + 1)), kn2 = __uint_as_float(ldu(C.nrm + 16 + h * 2)) + __uint_as_float(ldu(C.nrm + 16 + h * 2 + 1));
                const float thr_nat = (SKIP_THR + 2.0f * 1.01f * sqrtf(qn2 * kn2)) * (1.0f / LOG2E);
                const float lq0 = __uint_as_float(ldu((const unsigned*)(C.LCUM + (size_t)(256 * qb) * 8 + h)));
                LDS_WAIT();
                int cnt = 0;
#pragma unroll
                for (int j = 0; j < 4; ++j) { const int c = tref - 1 - (4 * lane + j); if (c >= 0 && (lq0 - dd[c + 1]) <= -thr_nat) ++cnt; }
#pragma unroll
                for (int o = 1; o < 64; o <<= 1) cnt += __shfl_xor(cnt, o);
                if (lane == 0) ((LAS int*)(lds + AL_MISC))[8] = cnt;
            }
        }
        __syncthreads();
        const int qc = SAMPLE ? 64 : (qrow >> 6);
        cq = (dd[qc] + C.LCUM[(size_t)qrow * 8 + h]) * LOG2E;
    }
    int t_start = 0;
    if (KIND == 0) t_start = ((const LAS int*)(lds + AL_MISC))[8];
    const int kkey = (tid & 7) + 8 * (tid >> 6), kc = (tid >> 3) & 7; const int kdst = kc * 1024 + kkey * 16;
    const int map_lo = (KIND == 1) ? umap : 0, map_hi = (KIND == 1) ? umap + 1 : NMAP;
    for (int map = map_lo; map < map_hi; ++map) {
        bf16x8 qr[4];
        { const bf16* qsrc = FOX ? (C.QF + (size_t)qrow * 512 + h * 64) : (C.DQ + (size_t)qrow * 512 + h * 128 + map * 64);
#pragma unroll
          for (int d0 = 0; d0 < 4; ++d0) qr[d0] = *(const bf16x8*)(qsrc + d0 * 16 + hi * 8); }
        f32x16 o[NDB];
#pragma unroll
        for (int d = 0; d < NDB; ++d) o[d] = (f32x16){0.f,0.f,0.f,0.f,0.f,0.f,0.f,0.f,0.f,0.f,0.f,0.f,0.f,0.f,0.f,0.f};
        float m_run = NEGBIG, l_run = 0.f;
        v4u kraw[2]; v4u vraw[NVC][2]; float ckraw = 0.f;
        kraw[0] = (v4u){0,0,0,0}; kraw[1] = (v4u){0,0,0,0};
#pragma unroll
        for (int i = 0; i < NVC; ++i) { vraw[i][0] = (v4u){0,0,0,0}; vraw[i][1] = (v4u){0,0,0,0}; }
        auto stage_load = [&](int t) {
            const bool f32src = SAMPLE && (t < 64);
            if (f32src) {
                const float* kp;
                if (FOX) kp = C.ck + ((size_t)(b * PAST + t * 64 + kkey) * 8 + h) * 64 + kc * 8;
                else kp = C.cdk + ((size_t)(b * PAST + t * 64 + kkey) * 4 + h) * 128 + map * 64 + kc * 8;
                kraw[0] = *(const v4u*)kp; kraw[1] = *(const v4u*)(kp + 4);
#pragma unroll
                for (int i = 0; i < NVC; ++i) { const int idx = tid + 512 * i, vkey = idx / (DV / 8), vc = idx % (DV / 8);
                    const float* vp = FOX ? (C.cv + ((size_t)(b * PAST + t * 64 + vkey) * 8 + h) * 64 + vc * 8) : (C.cdv + ((size_t)(b * PAST + t * 64 + vkey) * 4 + h) * 128 + vc * 8);
                    vraw[i][0] = *(const v4u*)vp; vraw[i][1] = *(const v4u*)(vp + 4); }
            } else {
                const size_t krow = SAMPLE ? (size_t)(NP + b * 64 + kkey) : (size_t)(t * 64 + kkey);
                const bf16* kp = FOX ? (C.KF + krow * 512 + h * 64 + kc * 8) : (C.DK + krow * 512 + h * 128 + map * 64 + kc * 8);
                kraw[0] = *(const v4u*)kp;
#pragma unroll
                for (int i = 0; i < NVC; ++i) { const int idx = tid + 512 * i, vkey = idx / (DV / 8), vc = idx % (DV / 8);
                    const size_t vrow = SAMPLE ? (size_t)(NP + b * 64 + vkey) : (size_t)(t * 64 + vkey);
                    const bf16* vp = FOX ? (C.VF + vrow * 512 + h * 64 + vc * 8) : (C.DV + vrow * 512 + h * 128 + vc * 8);
                    vraw[i][0] = *(const v4u*)vp; }
            }
            if (FOX && tid < 64) {
                float lv;
                if (SAMPLE) lv = (t < 64) ? C.LC[(size_t)(b * PAST + t * 64 + tid) * 8 + h] : C.LCUM[(size_t)(NP + b * 64 + tid) * 8 + h];
                else lv = C.LCUM[(size_t)(t * 64 + tid) * 8 + h];
                ckraw = lv;
            }
        };
        auto stage_write = [&](int t, int buf) {
            const bool f32src = SAMPLE && (t < 64);
            LAS unsigned char* kb = lds + AL_K + buf * 8192; LAS unsigned char* vb = lds + AL_V + buf * 16384;
            if (f32src) *(LAS bf16x8*)(kb + kdst) = cvt8(__builtin_bit_cast(f32x4, kraw[0]), __builtin_bit_cast(f32x4, kraw[1])); else *(LAS v4u*)(kb + kdst) = kraw[0];
#pragma unroll
            for (int i = 0; i < NVC; ++i) { const int idx = tid + 512 * i, vkey = idx / (DV / 8), vc = idx % (DV / 8);
                const int vdst = (vc >> 2) * 4096 + (vkey >> 4) * 1024 + (vkey & 15) * 64 + (vc & 3) * 16;
                if (f32src) *(LAS bf16x8*)(vb + vdst) = cvt8(__builtin_bit_cast(f32x4, vraw[i][0]), __builtin_bit_cast(f32x4, vraw[i][1])); else *(LAS v4u*)(vb + vdst) = vraw[i][0]; }
            if (FOX && tid < 64) ckt[buf * 64 + tid] = (dd[t] + ckraw) * LOG2E;
        };
        __syncthreads();
        stage_load(t_start); stage_write(t_start, t_start & 1);
        __syncthreads();
        for (int t = t_start; t < NT; ++t) {
            const int buf = t & 1;
            if (t + 1 < NT) stage_load(t + 1);
            if (compute_wave) {
                const LAS unsigned char* kt = lds + AL_K + buf * 8192; const LAS unsigned char* vt = lds + AL_V + buf * 16384;
                f32x16 p0, p1;
                if (FOX) {
#pragma unroll
                    for (int gq = 0; gq < 4; ++gq) { const f32x4 a = *(const LAS f32x4*)(ckt + buf * 64 + 8 * gq + 4 * hi), bq = *(const LAS f32x4*)(ckt + buf * 64 + 32 + 8 * gq + 4 * hi);
#pragma unroll
                        for (int e = 0; e < 4; ++e) { p0[4 * gq + e] = cq - a[e]; p1[4 * gq + e] = cq - bq[e]; } }
                } else {
                    const bool far_t = SAMPLE ? (t <= 61) : (t <= 4 * qb - 3);
                    const float c15 = far_t ? tab[0] : 0.f;
#pragma unroll
                    for (int r = 0; r < 16; ++r) { p0[r] = c15; p1[r] = c15; }
                }
                const LAS unsigned char* kbp = kt + hi * 1024 + r32 * 16;
#pragma unroll
                for (int d0 = 0; d0 < 4; ++d0) {
                    const bf16x8 b0 = *(const LAS bf16x8*)(kbp + d0 * 2048), b1 = *(const LAS bf16x8*)(kbp + d0 * 2048 + 512);
                    p0 = __builtin_amdgcn_mfma_f32_32x32x16_bf16(b0, qr[d0], p0, 0, 0, 0);
                    p1 = __builtin_amdgcn_mfma_f32_32x32x16_bf16(b1, qr[d0], p1, 0, 0, 0);
                }
                if (!FOX) {
                    const bool far_t = SAMPLE ? (t <= 61) : (t <= 4 * qb - 3);
#ifndef T_NONEAR
                    if (!far_t) {
#pragma unroll
                        for (int r = 0; r < 16; ++r) { const int rel0 = t * 64 + crow(r, hi) - qpos; int i0 = rel0 < -128 ? -128 : rel0; i0 = i0 > 63 ? 63 : i0; int i1 = rel0 + 32 < -128 ? -128 : rel0 + 32; i1 = i1 > 63 ? 63 : i1;
                            p0[r] += tab[i0 + 128]; p1[r] += tab[i1 + 128]; }
                    }
#endif
                    if (!SAMPLE) { if (t > (qpos >> 6)) {
#pragma unroll
                        for (int r = 0; r < 16; ++r) { p0[r] = NEGBIG; p1[r] = NEGBIG; } } }
                } else {
                    const bool band = SAMPLE ? (t == 64) : (t >= 4 * qb);
                    if (band) { const int kb0 = (SAMPLE ? PAST : t * 64);
#pragma unroll
                        for (int r = 0; r < 16; ++r) { const int kv = kb0 + crow(r, hi); if (kv > qpos) p0[r] = NEGBIG; if (kv + 32 > qpos) p1[r] = NEGBIG; } }
                }
                float rm = fmaxf(p0[0], p1[0]);
#pragma unroll
                for (int r = 1; r < 16; ++r) rm = fmaxf(rm, fmaxf(p0[r], p1[r]));
                rm = fmaxf(rm, __shfl_xor(rm, 32));
                if (__any(rm > m_run + RESC_THR)) {
                    const float m_new = fmaxf(m_run, rm); const float alpha = __builtin_amdgcn_exp2f(m_run - m_new); m_run = m_new;
                    l_run *= alpha;
                    if (hi == 0) wsf[r32] = alpha;
#pragma unroll
                    for (int gq = 0; gq < 4; ++gq) { const f32x4 a = *(const LAS f32x4*)(wsf + 8 * gq + 4 * hi);
#pragma unroll
                        for (int d = 0; d < NDB; ++d)
#pragma unroll
                            for (int e = 0; e < 4; ++e) o[d][4 * gq + e] *= a[e]; }
                }
                float rs = 0.f;
#pragma unroll
                for (int r = 0; r < 16; ++r) { p0[r] = __builtin_amdgcn_exp2f(p0[r] - m_run); p1[r] = __builtin_amdgcn_exp2f(p1[r] - m_run); rs += p0[r] + p1[r]; }
                l_run += rs;
                v4u pw[4];
                pw[0] = (v4u){pk2(p0[0], p0[1]), pk2(p0[2], p0[3]), pk2(p0[4], p0[5]), pk2(p0[6], p0[7])};
                pw[1] = (v4u){pk2(p0[8], p0[9]), pk2(p0[10], p0[11]), pk2(p0[12], p0[13]), pk2(p0[14], p0[15])};
                pw[2] = (v4u){pk2(p1[0], p1[1]), pk2(p1[2], p1[3]), pk2(p1[4], p1[5]), pk2(p1[6], p1[7])};
                pw[3] = (v4u){pk2(p1[8], p1[9]), pk2(p1[10], p1[11]), pk2(p1[12], p1[13]), pk2(p1[14], p1[15])};
                const LAS unsigned char* vp = vt + ((lane >> 4) & 1) * 32 + (lane & 3) * 8 + (4 * hi + ((lane & 15) >> 2)) * 64;
#pragma unroll
                for (int d = 0; d < NDB; ++d)
#pragma unroll
                    for (int ks = 0; ks < 4; ++ks) {
                        const s16x4 lo = vtr(vp + d * 4096 + ks * 1024), hh = vtr(vp + d * 4096 + ks * 1024 + 512);
                        const bf16x8 vf = (bf16x8){lo[0], lo[1], lo[2], lo[3], hh[0], hh[1], hh[2], hh[3]};
                        o[d] = __builtin_amdgcn_mfma_f32_32x32x16_bf16(__builtin_bit_cast(bf16x8, pw[ks]), vf, o[d], 0, 0, 0);
                        if (ks == 3) __builtin_amdgcn_sched_barrier(0);
                    }
            }
            if (t + 1 < NT) stage_write(t + 1, buf ^ 1);
            __syncthreads();
        }
        if (compute_wave) {
            int tidf = threadIdx.x; asm volatile("" : "+v"(tidf));
            const int lanef = tidf & 63;
            float lt = l_run + __shfl_xor(l_run, 32);
            const float inv = 1.0f / lt;
            if (hi == 0) wsf[r32] = inv;
            float rinv[16];
#pragma unroll
            for (int gq = 0; gq < 4; ++gq) { const f32x4 a = *(const LAS f32x4*)(wsf + 8 * gq + 4 * hi); rinv[4 * gq] = a[0]; rinv[4 * gq + 1] = a[1]; rinv[4 * gq + 2] = a[2]; rinv[4 * gq + 3] = a[3]; }
            const int rowb = SAMPLE ? (NP + b * 64 + 32 * (wid & 1)) : (256 * qb + 32 * wid);
            if (!FOX && map == 0) {
                const size_t slot = (KIND == 1) ? (size_t)(256 + (u & 255)) : (size_t)blockIdx.x;
                f32x4* st = (f32x4*)(C.stash + (slot * 512 + tidf) * (NDB * 16));
#pragma unroll
                for (int d = 0; d < NDB; ++d)
#pragma unroll
                    for (int gq = 0; gq < 4; ++gq) st[d * 4 + gq] = (f32x4){o[d][4 * gq] * rinv[4 * gq], o[d][4 * gq + 1] * rinv[4 * gq + 1], o[d][4 * gq + 2] * rinv[4 * gq + 2], o[d][4 * gq + 3] * rinv[4 * gq + 3]};
                if (KIND == 1) {
                    asm volatile("s_waitcnt vmcnt(0)" ::: "memory");
                    __syncthreads();
                    if (tidf == 0) { __builtin_amdgcn_fence(__ATOMIC_RELEASE, "agent"); asm volatile("s_waitcnt vmcnt(0)" ::: "memory");
                        __hip_atomic_store(C.flags + 16 * (u & 255), 1u, __ATOMIC_RELAXED, __HIP_MEMORY_SCOPE_AGENT); }
                }
            } else {
                LAS bf16* stg = (LAS bf16*)(lds + AL_STG) + wid * (32 * DV);
                if (FOX) {
#pragma unroll
                    for (int d = 0; d < NDB; ++d)
#pragma unroll
                        for (int r = 0; r < 16; ++r) stg[crow(r, hi) * DV + 32 * d + r32] = (bf16)f2bf(o[d][r] * rinv[r]);
                } else {
                    const size_t slot = (KIND == 1) ? (size_t)(256 + (u & 255)) : (size_t)blockIdx.x;
                    if (KIND == 1) {
                        if (tidf == 0) { unsigned sp = 0; while (__hip_atomic_load(C.flags + 16 * (u & 255), __ATOMIC_RELAXED, __HIP_MEMORY_SCOPE_AGENT) == 0u) { __builtin_amdgcn_s_sleep(8); if (++sp > (1u << 22)) break; }
                            __builtin_amdgcn_fence(__ATOMIC_ACQUIRE, "agent"); asm volatile("s_waitcnt vmcnt(0)" ::: "memory"); }
                        __syncthreads();
                    }
                    const f32x4* st = (const f32x4*)(C.stash + (slot * 512 + tidf) * (NDB * 16));
#pragma unroll
                    for (int d = 0; d < NDB; ++d)
#pragma unroll
                        for (int gq = 0; gq < 4; ++gq) { const f32x4 s1 = st[d * 4 + gq];
#pragma unroll
                            for (int e = 0; e < 4; ++e) { const int r = 4 * gq + e; stg[crow(r, hi) * DV + 32 * d + r32] = (bf16)f2bf(s1[e] - C.lam * (o[d][r] * rinv[r])); } }
                }
                LDS_WAIT(); asm volatile("" ::: "memory");
                constexpr int LPR = DV / 8;
                constexpr int RPP = 64 / LPR;
                const int cl = lanef % LPR;
#pragma unroll
                for (int ps = 0; ps < 32 / RPP; ++ps) {
                    const int rl = ps * RPP + lanef / LPR; const size_t row = (size_t)(rowb + rl);
                    const v4u sv = *(const LAS v4u*)(stg + rl * DV + cl * 8);
                    float xv[8];
                    xv[0] = __builtin_bit_cast(float, sv.x << 16); xv[1] = __builtin_bit_cast(float, sv.x & 0xffff0000u); xv[2] = __builtin_bit_cast(float, sv.y << 16); xv[3] = __builtin_bit_cast(float, sv.y & 0xffff0000u);
                    xv[4] = __builtin_bit_cast(float, sv.z << 16); xv[5] = __builtin_bit_cast(float, sv.z & 0xffff0000u); xv[6] = __builtin_bit_cast(float, sv.w << 16); xv[7] = __builtin_bit_cast(float, sv.w & 0xffff0000u);
                    const bf16* gp = FOX ? (C.GF + row * 512 + h * 64 + cl * 8) : (C.GD + row * 512 + h * 128 + cl * 8);
                    const v4u gv = *(const v4u*)gp;
                    float gg[8];
                    gg[0] = __builtin_bit_cast(float, gv.x << 16); gg[1] = __builtin_bit_cast(float, gv.x & 0xffff0000u); gg[2] = __builtin_bit_cast(float, gv.y << 16); gg[3] = __builtin_bit_cast(float, gv.y & 0xffff0000u);
                    gg[4] = __builtin_bit_cast(float, gv.z << 16); gg[5] = __builtin_bit_cast(float, gv.z & 0xffff0000u); gg[6] = __builtin_bit_cast(float, gv.w << 16); gg[7] = __builtin_bit_cast(float, gv.w & 0xffff0000u);
                    if (!FOX) {
                        float sq = 0.f;
#pragma unroll
                        for (int e = 0; e < 8; ++e) sq += xv[e] * xv[e];
#pragma unroll
                        for (int s = 1; s < LPR; s <<= 1) sq += __shfl_xor(sq, s);
                        const float rs = (1.0f / sqrtf(sq * (1.0f / 128.0f) + EPSN)) * 0.8f;
                        const f32x4 s0 = *(const f32x4*)(C.subln + cl * 8), s1 = *(const f32x4*)(C.subln + cl * 8 + 4);
#pragma unroll
                        for (int e = 0; e < 4; ++e) { xv[e] *= rs * s0[e]; xv[4 + e] *= rs * s1[e]; }
                    }
                    v4u ov; ov.x = pk2(xv[0] * gg[0], xv[1] * gg[1]); ov.y = pk2(xv[2] * gg[2], xv[3] * gg[3]); ov.z = pk2(xv[4] * gg[4], xv[5] * gg[5]); ov.w = pk2(xv[6] * gg[6], xv[7] * gg[7]);
                    bf16* op = FOX ? (C.MIX + row * 1024 + h * 64 + cl * 8) : (C.MIX + row * 1024 + 512 + h * 128 + cl * 8);
                    *(v4u*)op = ov;
                }
            }
        }
    }
}

template <int KIND>
__device__ __forceinline__ void attn_queue(const AttnCtx& C, unsigned* head, int nunits, LAS unsigned char* lds) {
    volatile LAS unsigned* slot = (volatile LAS unsigned*)(lds + AL_MISC);
    for (;;) {
        __syncthreads();
        if (threadIdx.x == 0) slot[0] = __hip_atomic_fetch_add(head, 1u, __ATOMIC_RELAXED, __HIP_MEMORY_SCOPE_AGENT);
        __syncthreads();
        const unsigned u = slot[0];
        if (u >= (unsigned)nunits) break;
        attn_unit<KIND>(C, (int)u, lds);
    }
}

__device__ __forceinline__ int t5_bucket(int rel) {
    const int n = rel < 0 ? -rel : rel; int bk;
    if (n < 8) bk = n; else bk = n < 12 ? 8 : n < 16 ? 9 : n < 23 ? 10 : n < 32 ? 11 : n < 46 ? 12 : n < 64 ? 13 : n < 91 ? 14 : 15;
    return bk + (rel > 0 ? 16 : 0);
}

__global__ void __launch_bounds__(NWAVES * 64, LBW) fwd_kernel(Args A) {
    extern __shared__ __attribute__((aligned(16))) unsigned char lds_raw[];
    LAS unsigned char* lds = (LAS unsigned char*)lds_raw;
    const int tid = threadIdx.x, lane = tid & 63; const int wave = __builtin_amdgcn_readfirstlane(tid >> 6);
    const int G = gridDim.x; const int bx = blockIdx.x; const int vcu = (G % 8 == 0) ? (bx % 8) * (G / 8) + bx / 8 : bx;
    volatile LAS unsigned* MISC = (volatile LAS unsigned*)(lds + MISC_OFF);
    for (int i = tid; i < (LDS_BYTES - MISC_OFF) / 4; i += NWAVES * 64) MISC[i] = 0u;
    __syncthreads();
    unsigned* ctl = (unsigned*)(A.ws + WS_CTL);
    XcdBarrier bar = xcd_barrier_post(ctl + CW_BAR, MISC + 8);

    p0_prologue(A, lds, vcu, G);
    xcd_barrier(bar);

    {
        pg8::Gemm g{(const pg8::bf16_t*)(A.ws + WS_H), (const pg8::bf16_t*)(A.ws + WS_WTIN), MT, 4096, D};
        pg8::StaticOrder S; S.init(MT, 4096, G, bx);
        pg8::EpiIn E{(pg8::bf16_t*)(A.ws + WS_SEG), SEG_BYTES / 2, A.out, C2, ctl + CW_NRM};
        pg8::gemm_phase<pg8::EpiIn, pg8::StaticOrder, true, true>(lds, g, S, E);
    }
    xcd_barrier(bar);

    {
        AttnCtx C;
        C.QF = (const bf16*)(A.ws + WS_SEG); C.KF = C.QF + SEG_BYTES / 2; C.VF = C.KF + SEG_BYTES / 2; C.GF = C.VF + SEG_BYTES / 2;
        C.DQ = C.GF + SEG_BYTES / 2; C.DK = C.DQ + SEG_BYTES / 2; C.DV = C.DK + SEG_BYTES / 2; C.GD = C.DV + SEG_BYTES / 2;
        C.MIX = (bf16*)(A.ws + WS_H);
        C.LCUM = (const float*)(A.ws + WS_LCUM); C.TTOT = (const float*)(A.ws + WS_TTOT); C.LC = (const float*)(A.ws + WS_LC); C.TC = (const float*)(A.ws + WS_TC);
        C.ck = A.ck; C.cv = A.cv; C.cdk = A.cdk; C.cdv = A.cdv; C.subln = A.subln; C.stash = (float*)(A.ws + WS_STASH); C.nrm = ctl + CW_NRM; C.flags = ctl + CW_FLAGS;
        LAS float* tabw = (LAS float*)(lds + AL_TAB); LAS float* misc = (LAS float*)(lds + AL_MISC);
        if (wave == 0) {
            const float a = wave_sum(A.lq1[lane] * A.lk1[lane]), c = wave_sum(A.lq2[lane] * A.lk2[lane]);
            if (lane == 0) misc[4] = expf(a) - expf(c) + 0.2f;
        }
        for (int i = tid; i < 4 * 192; i += 512) { const int hh = i / 192, rel = (i % 192) - 128; tabw[i] = A.relb[t5_bucket(rel) * 4 + hh] * LOG2E; }
        __syncthreads();
        C.lam = misc[4];
#ifndef NO_K1
        attn_queue<1>(C, ctl + CW_Q0, 512, lds);
#endif
#ifdef PROBE_PD2
        attn_queue<1>(C, ctl + 768, 512, lds);
#endif
#ifdef PROBE_S2
        attn_queue<3>(C, ctl + 832, 128, lds);
        attn_queue<2>(C, ctl + 896, 256, lds);
#endif
#ifndef NO_K3
        attn_queue<3>(C, ctl + CW_Q1, 128, lds);
#endif
#ifndef NO_K2
        attn_queue<2>(C, ctl + CW_Q2, 256, lds);
#endif
#ifndef NO_K0
        attn_queue<0>(C, ctl + CW_Q3, 512, lds);
#endif
    }
    xcd_barrier(bar);

    {
        pg8::Gemm g{(const pg8::bf16_t*)(A.ws + WS_H), (const pg8::bf16_t*)(A.ws + WS_WTOUT), MT, D, D};
        pg8::StaticOrder S; S.init(MT, D, G, bx);
        pg8::EpiOut E{(float*)(A.ws + WS_OUTF), (float*)(A.ws + WS_SS)};
        pg8::gemm_phase<pg8::EpiOut, pg8::StaticOrder, true, true>(lds, g, S, E);
    }
    xcd_barrier(bar);

    {
        const float* OUTF = (const float*)(A.ws + WS_OUTF); const float* SS = (const float*)(A.ws + WS_SS);
        const int gw = vcu * NWAVES + wave, NGW = G * NWAVES;
        f32x4 g[4];
#pragma unroll
        for (int j = 0; j < 4; ++j) g[j] = *(const f32x4*)(A.g_post + 4 * lane + 256 * j);
        for (int row = gw; row < MT; row += NGW) {
            const float sv = (lane < 16) ? SS[(size_t)row * 16 + lane] : 0.f;
            const float rstd = 1.0f / sqrtf(wave_sum(sv) * (1.0f / D) + EPSN);
            const float* xr = (row < NP) ? (A.x_p + (size_t)row * D) : (A.x_s + (size_t)(row - NP) * D);
            const float* orow = OUTF + (size_t)row * D; float* yr = A.out + (size_t)row * D;
#pragma unroll
            for (int j = 0; j < 4; ++j) { const f32x4 xv = *(const f32x4*)(xr + 4 * lane + 256 * j), ov = *(const f32x4*)(orow + 4 * lane + 256 * j);
                *(f32x4*)(yr + 4 * lane + 256 * j) = xv + ov * rstd * g[j]; }
        }
    }
}

extern "C" void kernel_launch(void* const* d_in, const int* in_sizes, int n_in, void* d_out, int out_size, void* d_ws, size_t ws_size, hipStream_t stream) {
    static int grid = 0;
    if (grid == 0) {
        if (n_in != 18 || in_sizes[0] != NP * D || (size_t)out_size != O_TOTAL || ws_size < WS_END) {
            fprintf(stderr, "kernel_launch: unexpected shapes: n_in %d in0 %d out %d ws %zu; nothing launched\n", n_in, n_in > 0 ? in_sizes[0] : -1, out_size, ws_size); grid = -1; return; }
        int dev = 0, cus = 0, per_cu = 0;
        if (hipGetDevice(&dev) != hipSuccess || hipDeviceGetAttribute(&cus, hipDeviceAttributeMultiprocessorCount, dev) != hipSuccess) { grid = -1; return; }
        if (hipFuncSetAttribute((const void*)fwd_kernel, hipFuncAttributeMaxDynamicSharedMemorySize, LDS_BYTES) != hipSuccess) { fprintf(stderr, "kernel_launch: hipFuncSetAttribute failed\n"); grid = -1; return; }
        if (hipOccupancyMaxActiveBlocksPerMultiprocessor(&per_cu, (const void*)fwd_kernel, NWAVES * 64, LDS_BYTES) != hipSuccess || per_cu < 1) {
            fprintf(stderr, "kernel_launch: occupancy query says %d blocks per CU; nothing launched\n", per_cu); (void)hipGetLastError(); grid = -1; return; }
        grid = cus;
    }
    if (grid < 0) return;
    (void)hipMemsetAsync((char*)d_ws + WS_CTL, 0, CTL_ZERO_BYTES, stream);
    Args a{};
    a.x_p = (const float*)d_in[0]; a.x_s = (const float*)d_in[1]; a.ck = (const float*)d_in[2]; a.cv = (const float*)d_in[3]; a.clf = (const float*)d_in[4];
    a.cdk = (const float*)d_in[5]; a.cdv = (const float*)d_in[6]; a.g_pre = (const float*)d_in[7]; a.w_in = (const float*)d_in[8]; a.b_f = (const float*)d_in[9];
    a.lq1 = (const float*)d_in[10]; a.lk1 = (const float*)d_in[11]; a.lq2 = (const float*)d_in[12]; a.lk2 = (const float*)d_in[13]; a.subln = (const float*)d_in[14];
    a.w_out = (const float*)d_in[15]; a.g_post = (const float*)d_in[16]; a.relb = (const float*)d_in[17];
    a.out = (float*)d_out; a.ws = (unsigned char*)d_ws;
    hipLaunchKernelGGL(fwd_kernel, dim3(grid), dim3(NWAVES * 64), LDS_BYTES, stream, a);
    const hipError_t le = hipPeekAtLastError();
    if (le != hipSuccess) fprintf(stderr, "kernel_launch: launch failed: %s\n", hipGetErrorName(le));
}
```

```cpp
#include <hip/hip_runtime.h>
#include <cstdio>
#include <cstdint>
#define GAS __attribute__((address_space(1)))
#define LAS __attribute__((address_space(3)))
namespace pg8 {
#define PG8_LAS __attribute__((address_space(3)))
typedef unsigned short bf16_t;
typedef short bf16x8 __attribute__((ext_vector_type(8)));
typedef float f32x4 __attribute__((ext_vector_type(4)));
typedef unsigned u32x4 __attribute__((ext_vector_type(4)));
constexpr int BM = 256, BK = 64, HALF = 128, HTB = HALF * BK * 2  , STAGE_BYTES = 8 * HTB, NXCD = 8, WGM = 8;

__host__ __device__ __forceinline__ int lds_byte(int r, int c) { const int st = (r >> 4) * 2 + (c >> 5), rr = r & 15, cc = c & 31, ob = rr * 64 + cc * 2; return st * 1024 + (ob ^ (((ob >> 9) & 1) << 5)); }
__host__ __device__ __forceinline__ void stage_rc(int b, int& R, int& C) { const int st = b / 1024, sb = b % 1024, swz = sb ^ (((sb >> 9) & 1) << 5); R = (st >> 1) * 16 + swz / 64; C = (st & 1) * 32 + (swz % 64) / 2; }
__host__ __device__ __forceinline__ int perm32(int rho) { const int n = rho >> 4, i = rho & 15; return 8 * (i >> 2) + 4 * n + (i & 3); }

struct Unit { int pm, pn; };
struct Gemm { const bf16_t* A; const bf16_t* Bt; int M, N, K; };

struct StaticOrder {
    int nM, nN, nwg, G, c;
    __host__ __device__ void init(int M, int N, int G_, int c_) { nM = M / BM; nN = N / BM; nwg = nM * nN; G = G_; c = c_; }
    __host__ __device__ bool next(int i, Unit& u) const {
        const long L = (long)i * G + c; if (L >= nwg) return false;
        int wgid = (int)L; { const int q = nwg / NXCD, r = nwg % NXCD, xcd = wgid % NXCD, off = wgid / NXCD; wgid = (xcd < r ? xcd * (q + 1) : r * (q + 1) + (xcd - r) * q) + off; }
        const int nig = WGM * nN, gid = wgid / nig, fm = gid * WGM, gsz = (nM - fm) < WGM ? (nM - fm) : WGM;
        u.pm = fm + ((wgid % nig) % gsz); u.pn = (wgid % nig) / gsz; return true;
    }
    __device__ __forceinline__ void a_ready(const Unit&) const {}
    __device__ __forceinline__ void done(const Unit&) const {}
};

__device__ __forceinline__ unsigned cvt_pk_bf16(float lo, float hi) { unsigned r; asm volatile("v_cvt_pk_bf16_f32 %0, %1, %2" : "=v"(r) : "v"(lo), "v"(hi)); return r; }
typedef float f32x2 __attribute__((ext_vector_type(2)));
typedef float f32x2 __attribute__((ext_vector_type(2)));
__device__ __forceinline__ float silu_f(float x) { return x * __builtin_amdgcn_rcpf(1.0f + __builtin_amdgcn_exp2f(-1.4426950408889634f * x)); }
struct EpiIn {
    static constexpr bool PERM = true, AFTER_DRAIN = false;
    bf16_t* segbase; size_t segstride;
    float* out;
    float c2; unsigned* nrm;
    __device__ __forceinline__ void norm_max(const f32x4 (&acc)[2][2][4][2], const Unit& u, int wc, float sc, int base) const {
        float mx[2] = {0.f, 0.f};
#pragma unroll
        for (int ai = 0; ai < 2; ++ai)
#pragma unroll
            for (int m = 0; m < 4; ++m)
#pragma unroll
                for (int bj = 0; bj < 2; ++bj) { const f32x4 a = acc[ai][bj][m][0] * sc, b = acc[ai][bj][m][1] * sc;
                    float s = (a[0] * a[0] + a[1] * a[1]) + (a[2] * a[2] + a[3] * a[3]) + (b[0] * b[0] + b[1] * b[1]) + (b[2] * b[2] + b[3] * b[3]);
                    s += __shfl_xor(s, 16); s += __shfl_xor(s, 32); mx[bj] = fmaxf(mx[bj], s); }
#pragma unroll
        for (int bj = 0; bj < 2; ++bj) {
#pragma unroll
            for (int o = 1; o < 16; o <<= 1) mx[bj] = fmaxf(mx[bj], __shfl_xor(mx[bj], o));
            if ((threadIdx.x & 63) == 0) { const int head = (u.pn & 1) * 4 + bj * 2 + (wc >> 1); atomicMax(nrm + base + head * 2 + (wc & 1), __float_as_uint(mx[bj])); } }
    }
    __device__ __forceinline__ void operator()(const f32x4 (&acc)[2][2][4][2], const Unit& u, int wr, int wc, int fr, int fq) const {
        const int seg = u.pn >> 1;
        const int col0 = (u.pn & 1) * 256 + wc * 32 + 8 * fq;
        const int row0 = u.pm * BM + wr * 64 + fr;
        bf16_t* bb = segbase + (size_t)seg * segstride;
        const bool is_s = (u.pm >= 64);
        const int mode = (seg == 0 || seg == 4) ? 0 : ((seg == 3 || seg == 7) ? 2 : 1);
        if (seg == 0) norm_max(acc, u, wc, c2, 0);
        if (seg == 1) norm_max(acc, u, wc, 1.0f, 16);
        if (mode == 1) {
            const size_t offp = seg == 1 ? (size_t)18874368 : seg == 2 ? (size_t)27262976 : seg == 5 ? (size_t)35782656 : (size_t)44171264;
            const size_t offs = seg == 1 ? (size_t)52559872 : seg == 2 ? (size_t)53608448 : seg == 5 ? (size_t)54673408 : (size_t)55721984;
            float* fb = out + (is_s ? offs : offp);
            const int rsub = is_s ? 16384 : 0;
#pragma unroll
            for (int ai = 0; ai < 2; ++ai)
#pragma unroll
                for (int m = 0; m < 4; ++m) { const int row = row0 + ai * HALF + m * 16;
                    bf16_t* rowp = bb + (size_t)row * 512 + col0; float* frow = fb + (size_t)(row - rsub) * 512 + col0;
#pragma unroll
                    for (int bj = 0; bj < 2; ++bj) { const f32x4 v0 = acc[ai][bj][m][0], v1 = acc[ai][bj][m][1];
                        *(f32x4*)(frow + bj * HALF) = v0; *(f32x4*)(frow + bj * HALF + 4) = v1;
                        u32x4 w; w.x = cvt_pk_bf16(v0[0], v0[1]); w.y = cvt_pk_bf16(v0[2], v0[3]); w.z = cvt_pk_bf16(v1[0], v1[1]); w.w = cvt_pk_bf16(v1[2], v1[3]);
                        *(u32x4*)(rowp + bj * HALF) = w; } }
        } else if (mode == 0) {
            const float sc = c2;
#pragma unroll
            for (int ai = 0; ai < 2; ++ai)
#pragma unroll
                for (int m = 0; m < 4; ++m) { const int row = row0 + ai * HALF + m * 16; bf16_t* rowp = bb + (size_t)row * 512 + col0;
#pragma unroll
                    for (int bj = 0; bj < 2; ++bj) { const f32x4 v0 = acc[ai][bj][m][0] * sc, v1 = acc[ai][bj][m][1] * sc;
                        u32x4 w; w.x = cvt_pk_bf16(v0[0], v0[1]); w.y = cvt_pk_bf16(v0[2], v0[3]); w.z = cvt_pk_bf16(v1[0], v1[1]); w.w = cvt_pk_bf16(v1[2], v1[3]);
                        *(u32x4*)(rowp + bj * HALF) = w; } }
        } else {
#pragma unroll
            for (int ai = 0; ai < 2; ++ai)
#pragma unroll
                for (int m = 0; m < 4; ++m) { const int row = row0 + ai * HALF + m * 16; bf16_t* rowp = bb + (size_t)row * 512 + col0;
#pragma unroll
                    for (int bj = 0; bj < 2; ++bj) { const f32x4 a0 = acc[ai][bj][m][0], a1 = acc[ai][bj][m][1];
                        u32x4 w; w.x = cvt_pk_bf16(silu_f(a0[0]), silu_f(a0[1])); w.y = cvt_pk_bf16(silu_f(a0[2]), silu_f(a0[3]));
                        w.z = cvt_pk_bf16(silu_f(a1[0]), silu_f(a1[1])); w.w = cvt_pk_bf16(silu_f(a1[2]), silu_f(a1[3]));
                        *(u32x4*)(rowp + bj * HALF) = w; } }
        }
    }
};
struct EpiOut {
    static constexpr bool PERM = false, AFTER_DRAIN = false;
    float* outf; float* ss;
    __device__ __forceinline__ void operator()(const f32x4 (&acc)[2][2][4][2], const Unit& u, int wr, int wc, int fr, int fq) const {
        const int col0 = u.pn * BM + wc * 32 + 4 * fq;
#pragma unroll
        for (int ai = 0; ai < 2; ++ai)
#pragma unroll
            for (int m = 0; m < 4; ++m) { const int row = u.pm * BM + ai * HALF + wr * 64 + m * 16 + fr; float* rp = outf + (size_t)row * 1024 + col0; float s = 0.f;
#pragma unroll
                for (int bj = 0; bj < 2; ++bj)
#pragma unroll
                    for (int n = 0; n < 2; ++n) { const f32x4 v = acc[ai][bj][m][n]; *(f32x4*)(rp + bj * HALF + n * 16) = v; s += (v[0] * v[0] + v[1] * v[1]) + (v[2] * v[2] + v[3] * v[3]); }
                s += __shfl_xor(s, 16); s += __shfl_xor(s, 32);
                if (fq == 0) ss[(size_t)row * 16 + u.pn * 4 + wc] = s; }
    }
};
template <class Epi, class Sched, bool ALIGN_EPI = false, bool SP2 = false>
__device__ __forceinline__ void gemm_phase(PG8_LAS unsigned char* lds, const Gemm g, const Sched& S, const Epi& E) {
    const int tid = threadIdx.x, wid = __builtin_amdgcn_readfirstlane(tid >> 6), lane = tid & 63, wr = wid >> 2, wc = wid & 3, fr = lane & 15, fq = lane >> 4;
    const int K = g.K, nt = K / BK;
    unsigned voffA[2], voffB[2];
#pragma unroll
    for (int i = 0; i < 2; ++i) { int R, C; stage_rc(tid * 16 + i * 8192, R, C); const int Rb = Epi::PERM ? ((R & ~31) + perm32(R & 31)) : R;
        voffA[i] = (unsigned)(R * K + C) * 2u; voffB[i] = (unsigned)(Rb * K + C) * 2u; }
    const size_t kstep = (size_t)(BK * 2);
    const size_t hstep = (size_t)HALF * K * 2;
    const size_t tstep = 2 * hstep;
    const unsigned ldsw = (unsigned)wid * 1024u;
    const int aoff = lds_byte(wr * 64 + fr, fq * 8), boff = lds_byte(wc * 32 + fr, fq * 8);
#define PG8_SA(b, h) (((b) * 2 + (h)) * HTB)
#define PG8_SB(b, h) ((4 + (b) * 2 + (h)) * HTB)
#define PG8_STAGE(bufoff, gbase, voff) do { _Pragma("unroll") for (int _i = 0; _i < 2; ++_i) \
        __builtin_amdgcn_global_load_lds((const unsigned*)((const char*)(gbase) + (voff)[_i]), (PG8_LAS unsigned*)(lds + (bufoff) + ldsw + _i * 8192), 16, 0, 0); } while (0)
#define PG8_LDA(dst, b, h) do { _Pragma("unroll") for (int m = 0; m < 4; ++m) _Pragma("unroll") for (int k = 0; k < 2; ++k) dst[m][k] = *(const PG8_LAS bf16x8*)(lds + PG8_SA(b, h) + aoff + m * 2048 + k * 1024); } while (0)
#define PG8_LDB(dst, b, h) do { _Pragma("unroll") for (int n = 0; n < 2; ++n) _Pragma("unroll") for (int k = 0; k < 2; ++k) dst[n][k] = *(const PG8_LAS bf16x8*)(lds + PG8_SB(b, h) + boff + n * 2048 + k * 1024); } while (0)
#define PG8_MMA(ai, bj, At, Bt) do { __builtin_amdgcn_s_setprio(1); _Pragma("unroll") for (int m = 0; m < 4; ++m) _Pragma("unroll") for (int n = 0; n < 2; ++n) _Pragma("unroll") for (int k = 0; k < 2; ++k) \
        acc[ai][bj][m][n] = __builtin_amdgcn_mfma_f32_16x16x32_bf16(Bt[n][k], At[m][k], acc[ai][bj][m][n], 0, 0, 0); __builtin_amdgcn_s_setprio(0); } while (0)
#define PG8_WAIT_V(n) asm volatile("s_waitcnt vmcnt(" #n ")" ::: "memory")
#define PG8_WAIT_L(n) asm volatile("s_waitcnt lgkmcnt(" #n ")" ::: "memory")
#define PG8_BAR __builtin_amdgcn_s_barrier()
#define PG8_SCHED __builtin_amdgcn_sched_barrier(0)
    Unit cur, nxt; int ui = 0;
    if (!S.next(0, cur)) return;
    f32x4 acc[2][2][4][2];
#pragma unroll
    for (int a = 0; a < 2; ++a)
#pragma unroll
        for (int b = 0; b < 2; ++b)
#pragma unroll
            for (int m = 0; m < 4; ++m)
#pragma unroll
                for (int n = 0; n < 2; ++n) acc[a][b][m][n] = (f32x4){0.f, 0.f, 0.f, 0.f};
    bf16x8 At[4][2], B0[2][2], B1[2][2];
    const char* cA = (const char*)g.A + (size_t)cur.pm * tstep; const char* cB = (const char*)g.Bt + (size_t)cur.pn * tstep;
    S.a_ready(cur);
    if constexpr (SP2) {
        PG8_STAGE(PG8_SB(0, 0), cB, voffB); PG8_STAGE(PG8_SB(0, 1), cB + hstep, voffB); PG8_STAGE(PG8_SA(0, 0), cA, voffA); PG8_STAGE(PG8_SA(0, 1), cA + hstep, voffA);
        if (wr == 1) PG8_BAR;
        PG8_WAIT_V(2); PG8_BAR;
        PG8_STAGE(PG8_SB(1, 0), cB + kstep, voffB); PG8_STAGE(PG8_SA(1, 0), cA + kstep, voffA); PG8_STAGE(PG8_SB(1, 1), cB + hstep + kstep, voffB);
        PG8_WAIT_V(6); PG8_BAR;
    } else {
        PG8_STAGE(PG8_SB(0, 0), cB, voffB); PG8_STAGE(PG8_SA(0, 0), cA, voffA); PG8_STAGE(PG8_SB(0, 1), cB + hstep, voffB); PG8_STAGE(PG8_SA(0, 1), cA + hstep, voffA);
        if (wr == 1) PG8_BAR;
        PG8_WAIT_V(4); PG8_BAR;
        PG8_STAGE(PG8_SB(1, 0), cB + kstep, voffB); PG8_STAGE(PG8_SA(1, 0), cA + kstep, voffA); PG8_STAGE(PG8_SB(1, 1), cB + hstep + kstep, voffB);
        PG8_WAIT_V(6); PG8_BAR;
    }
    for (;;) {
        const bool has_next = S.next(ui + 1, nxt);
        const char* nA = has_next ? (const char*)g.A + (size_t)nxt.pm * tstep : cA; const char* nB = has_next ? (const char*)g.Bt + (size_t)nxt.pn * tstep : cB;
        for (int t = 0; t < nt; t += 2) {
            const bool last = (t == nt - 2);
            const char* a1 = cA + (size_t)(t + 1) * kstep;
            const char* a2 = last ? nA : cA + (size_t)(t + 2) * kstep; const char* b2 = last ? nB : cB + (size_t)(t + 2) * kstep;
            const char* a3 = a2 + kstep; const char* b3 = b2 + kstep;
            if (last && has_next) S.a_ready(nxt);
            if constexpr (SP2) {
            PG8_LDB(B0, 0, 0); PG8_LDB(B1, 0, 1); PG8_SCHED; PG8_LDA(At, 0, 0); PG8_STAGE(PG8_SA(1, 1), a1 + hstep, voffA);
            PG8_WAIT_V(8); PG8_WAIT_L(0); PG8_BAR; PG8_MMA(0, 0, At, B0); PG8_MMA(0, 1, At, B1); PG8_BAR; PG8_SCHED;
            PG8_LDA(At, 0, 1); PG8_STAGE(PG8_SB(0, 0), b2, voffB); PG8_STAGE(PG8_SB(0, 1), b2 + hstep, voffB); PG8_STAGE(PG8_SA(0, 0), a2, voffA);
            PG8_WAIT_V(8); PG8_WAIT_L(0); PG8_BAR; PG8_MMA(1, 0, At, B0); PG8_MMA(1, 1, At, B1); PG8_BAR; PG8_SCHED;
            PG8_LDB(B0, 1, 0); PG8_LDB(B1, 1, 1); PG8_SCHED; PG8_LDA(At, 1, 0); PG8_STAGE(PG8_SA(0, 1), a2 + hstep, voffA);
            PG8_WAIT_V(8); PG8_WAIT_L(0); PG8_BAR; PG8_MMA(0, 0, At, B0); PG8_MMA(0, 1, At, B1); PG8_BAR; PG8_SCHED;
            PG8_LDA(At, 1, 1); PG8_STAGE(PG8_SB(1, 0), b3, voffB); PG8_STAGE(PG8_SB(1, 1), b3 + hstep, voffB); PG8_STAGE(PG8_SA(1, 0), a3, voffA);
            PG8_WAIT_V(8); PG8_WAIT_L(0); PG8_BAR; PG8_MMA(1, 0, At, B0); PG8_MMA(1, 1, At, B1); PG8_BAR; PG8_SCHED;
            } else {
            PG8_LDB(B0, 0, 0); PG8_SCHED; PG8_LDA(At, 0, 0); PG8_STAGE(PG8_SA(1, 1), a1 + hstep, voffA);
            PG8_WAIT_L(8); PG8_BAR; PG8_WAIT_L(0); PG8_MMA(0, 0, At, B0); PG8_BAR; PG8_SCHED;
            PG8_LDB(B1, 0, 1); PG8_STAGE(PG8_SB(0, 0), b2, voffB);
            PG8_BAR; PG8_WAIT_L(0); PG8_MMA(0, 1, At, B1); PG8_BAR;
            PG8_LDA(At, 0, 1); PG8_STAGE(PG8_SA(0, 0), a2, voffA);
            PG8_BAR; PG8_WAIT_L(0); PG8_MMA(1, 0, At, B0); PG8_BAR; PG8_SCHED;
            PG8_STAGE(PG8_SB(0, 1), b2 + hstep, voffB);
            PG8_WAIT_V(6); PG8_BAR; PG8_MMA(1, 1, At, B1); PG8_BAR;
            PG8_LDB(B0, 1, 0); PG8_SCHED; PG8_LDA(At, 1, 0); PG8_STAGE(PG8_SA(0, 1), a2 + hstep, voffA);
            PG8_WAIT_L(8); PG8_BAR; PG8_WAIT_L(0); PG8_MMA(0, 0, At, B0); PG8_BAR; PG8_SCHED;
            PG8_LDB(B1, 1, 1); PG8_STAGE(PG8_SB(1, 0), b3, voffB);
            PG8_BAR; PG8_WAIT_L(0); PG8_MMA(0, 1, At, B1); PG8_BAR;
            PG8_LDA(At, 1, 1); PG8_STAGE(PG8_SA(1, 0), a3, voffA);
            PG8_BAR; PG8_WAIT_L(0); PG8_MMA(1, 0, At, B0); PG8_BAR; PG8_SCHED;
            PG8_STAGE(PG8_SB(1, 1), b3 + hstep, voffB);
            PG8_WAIT_V(6); PG8_BAR; PG8_MMA(1, 1, At, B1); PG8_BAR;
            }
        }
        if constexpr (ALIGN_EPI) { if (wr == 0) PG8_BAR; }
        if constexpr (!Epi::AFTER_DRAIN) { E(acc, cur, wr, wc, fr, fq); S.done(cur); }
        if (!has_next) break;
#pragma unroll
        for (int a = 0; a < 2; ++a)
#pragma unroll
            for (int b = 0; b < 2; ++b)
#pragma unroll
                for (int m = 0; m < 4; ++m)
#pragma unroll
                    for (int n = 0; n < 2; ++n) acc[a][b][m][n] = (f32x4){0.f, 0.f, 0.f, 0.f};
        cur = nxt; cA = nA; cB = nB; ++ui;
        if constexpr (ALIGN_EPI) { if (wr == 1) PG8_BAR; }
    }
    PG8_WAIT_V(0);
    if constexpr (!ALIGN_EPI) { if (wr == 0) PG8_BAR; }
    PG8_BAR;
    if constexpr (Epi::AFTER_DRAIN) { E.fused(acc, cur, wr, wc, fr, fq, lds, wid, lane); S.done(cur); }
#undef PG8_SA
#undef PG8_SB
#undef PG8_STAGE
#undef PG8_LDA
#undef PG8_LDB
#undef PG8_MMA
#undef PG8_WAIT_V
#undef PG8_WAIT_L
#undef PG8_BAR
#undef PG8_SCHED
}
}
#define XB_TMO      128
#define XB_XCNT(j)  (256  + 64 * (j))
#define XB_XSUB(j)  (1280 + 64 * (j))
#define XB_XGEN(j)  (2304 + 64 * (j))
#define XB_TOP      3328
#define XB_TOPGEN   3392
#define XCD_BAR_WORDS 3456
#define XB_SPIN_CAP (1u << 18)

__device__ __forceinline__ unsigned xb_ld(unsigned* p)              { return __hip_atomic_load(p, __ATOMIC_RELAXED, __HIP_MEMORY_SCOPE_AGENT); }
__device__ __forceinline__ unsigned xb_add(unsigned* p, unsigned v) { return __hip_atomic_fetch_add(p, v, __ATOMIC_RELAXED, __HIP_MEMORY_SCOPE_AGENT); }
__device__ __forceinline__ unsigned xb_xcc_id() { return (unsigned)__builtin_amdgcn_s_getreg((3 << 11) | 20) & 0xFu; }
#define XB_SPIN(cond, bar) do { unsigned _sp = 0; while (cond) { __builtin_amdgcn_s_sleep(1); \
    if ((++_sp & 255u) == 0u) { if (xb_ld(&(bar)[XB_TMO])) break; if (_sp > XB_SPIN_CAP) { atomicAdd(&(bar)[XB_TMO], 1u); break; } } } } while (0)

struct XcdBarrier {
    unsigned* bar; unsigned x;
    volatile LAS unsigned* st;
};

__device__ __forceinline__ XcdBarrier xcd_barrier_post(unsigned* bar, volatile LAS unsigned* st) {
    XcdBarrier b; b.bar = bar; b.x = xb_xcc_id(); b.st = st;
    if (threadIdx.x == 0) (void)xb_add(&bar[XB_XCNT(b.x)], 1u);
    return b;
}
__device__ __forceinline__ void xcd_barrier_complete(unsigned* bar, unsigned x, unsigned& nloc, unsigned& nx) {
    const unsigned G = gridDim.x * gridDim.y * gridDim.z;
    unsigned sum, cnt, mine, sp = 0u;
    for (;;) {
        sum = 0u; cnt = 0u; mine = 0u;
#pragma unroll
        for (unsigned j = 0; j < 16; ++j) { const unsigned c = xb_ld(&bar[XB_XCNT(j)]); sum += c; cnt += (c > 0u) ? 1u : 0u; mine = (j == x) ? c : mine; }
        if (sum == G) break;
        __builtin_amdgcn_s_sleep(1);
        if ((++sp & 255u) == 0u) { if (xb_ld(&bar[XB_TMO])) break; if (sp > XB_SPIN_CAP) { atomicAdd(&bar[XB_TMO], 1u); break; } }
    }
    nloc = mine > 0u ? mine : 1u; nx = cnt > 0u ? cnt : 1u;
}

__device__ __forceinline__ void xcd_barrier(const XcdBarrier& b) {
    asm volatile("s_waitcnt vmcnt(0)" ::: "memory");
    __syncthreads();
    if (threadIdx.x == 0) {
        unsigned* bar = b.bar;
        __builtin_amdgcn_s_waitcnt(0);
        unsigned nloc = b.st[0], nx = b.st[1];
        if (nloc == 0u) { xcd_barrier_complete(bar, b.x, nloc, nx); b.st[0] = nloc; b.st[1] = nx; }
        const unsigned old = xb_add(&bar[XB_XSUB(b.x)], 1u);
        const unsigned gen = old / nloc;
        if (old + 1u == (gen + 1u) * nloc) {
            __builtin_amdgcn_fence(__ATOMIC_RELEASE, "agent");
            asm volatile("s_waitcnt vmcnt(0)" ::: "memory");
            const unsigned og = xb_add(&bar[XB_TOP], 1u);
            const unsigned tg = og / nx;
            if (og + 1u == (tg + 1u) * nx) xb_add(&bar[XB_TOPGEN], 1u);
            else XB_SPIN(xb_ld(&bar[XB_TOPGEN]) == tg, bar);
            __builtin_amdgcn_fence(__ATOMIC_ACQUIRE, "agent");
            xb_add(&bar[XB_XGEN(b.x)], 1u);
            asm volatile("s_waitcnt vmcnt(0)" ::: "memory");
        } else {
            XB_SPIN(xb_ld(&bar[XB_XGEN(b.x)]) == gen, bar);
            __builtin_amdgcn_fence(__ATOMIC_ACQUIRE, "agent");
            asm volatile("s_waitcnt vmcnt(0)" ::: "memory");
        }
    }
    __syncthreads();
}

constexpr int NWAVES = 8;
#ifndef LBW
#define LBW 2
#endif
constexpr int D = 1024, NP = 16384, NS = 2048, MT = NP + NS;
constexpr int PAST = 4096, NB = 32;
constexpr int WIN_LD = 4104;
constexpr float EPSN = 1e-6f;
constexpr float LOG2E = 1.4426950408889634f;
constexpr float C2 = 0.125f * LOG2E;
constexpr float NEGBIG = -1e30f;
constexpr float SKIP_THR = 48.0f;
constexpr float RESC_THR = 8.0f;
constexpr size_t O_FKP = 18874368, O_FVP = 27262976, O_LFP = 35651584, O_DKP = 35782656, O_DVP = 44171264, O_FKS = 52559872, O_FVS = 53608448, O_LFS = 54657024, O_DKS = 54673408, O_DVS = 55721984, O_TOTAL = 56770560;
constexpr size_t MiB = 1u << 20;
constexpr size_t WS_CTL = 0, CTL_ZERO_BYTES = 65536;
constexpr size_t WS_WTIN = 2 * MiB, WS_WTOUT = 10 * MiB, WS_LCUM = 12 * MiB, WS_TTOT = 13 * MiB, WS_LC = 14 * MiB, WS_TC = 18 * MiB, WS_SS = 19 * MiB;
constexpr size_t WS_H = 32 * MiB;
constexpr size_t WS_SEG = 68 * MiB, SEG_BYTES = 18 * MiB;
constexpr size_t WS_STASH = 316 * MiB;
constexpr size_t WS_OUTF = 244 * MiB;
constexpr size_t WS_END = 380 * MiB;
constexpr int CW_BAR = 4096;
constexpr int CW_Q0 = 64, CW_Q1 = 128, CW_Q2 = 192, CW_Q3 = 256;
constexpr int CW_FLAGS = 8192;
constexpr int CW_NRM = 512;
constexpr int RING_BYTES = 131072;
constexpr int MISC_OFF = RING_BYTES;
constexpr int LDS_BYTES = 147456;

typedef unsigned short bf16;
typedef unsigned v4u __attribute__((ext_vector_type(4)));
typedef float f32x4 __attribute__((ext_vector_type(4)));
typedef float f32x16 __attribute__((ext_vector_type(16)));
typedef short bf16x8 __attribute__((ext_vector_type(8)));
typedef short s16x4 __attribute__((ext_vector_type(4)));
typedef short v4i16_t __attribute__((ext_vector_type(4)));
#define LDS_WAIT() asm volatile("s_waitcnt lgkmcnt(0)" ::: "memory")

__device__ __forceinline__ unsigned f2bf(float f) { unsigned u = __builtin_bit_cast(unsigned, f); return (u + 0x7fffu + ((u >> 16) & 1u)) >> 16; }
typedef float f32x2_t __attribute__((ext_vector_type(2))); typedef __bf16 bf16x2_t __attribute__((ext_vector_type(2)));
__device__ __forceinline__ unsigned pk2(float lo, float hi) { f32x2_t v = {lo, hi}; bf16x2_t b = __builtin_convertvector(v, bf16x2_t); return __builtin_bit_cast(unsigned, b); }
__device__ __forceinline__ float bf2f(unsigned short b) { return __builtin_bit_cast(float, (unsigned)b << 16); }
__device__ __forceinline__ float wave_sum(float v) {
#pragma unroll
    for (int o = 1; o < 64; o <<= 1) v += __shfl_xor(v, o);
    return v;
}
__device__ __forceinline__ unsigned ldu(const unsigned* p) { return __hip_atomic_load(p, __ATOMIC_RELAXED, __HIP_MEMORY_SCOPE_AGENT); }
__device__ __forceinline__ int crow(int r, int hi) { return (r & 3) + 8 * (r >> 2) + 4 * hi; }

struct Args {
    const float* x_p; const float* x_s; const float* ck; const float* cv; const float* clf; const float* cdk; const float* cdv;
    const float* g_pre; const float* w_in; const float* b_f; const float* lq1; const float* lk1; const float* lq2; const float* lk2;
    const float* subln; const float* w_out; const float* g_post; const float* relb;
    float* out; unsigned char* ws;
};

__device__ __forceinline__ void p0_transpose_item(const float* W, int ldw, int K, int nblk, int split, int skip, bf16* WT, LAS float* scr, int item, int lane) {
    const int kb = item / nblk, nb = item % nblk, k0 = 64 * kb, n0 = 32 * nb, w0 = n0 + (n0 >= split ? skip : 0);
#pragma unroll 8
    for (int i = 0; i < 32; ++i) { const int kk = 2 * i + (lane >> 5); scr[kk * 33 + (lane & 31)] = W[(size_t)(k0 + kk) * ldw + w0 + (lane & 31)]; }
    LDS_WAIT(); asm volatile("" ::: "memory");
    const int c = lane & 7;
#pragma unroll
    for (int j = 0; j < 4; ++j) { const int n = (lane >> 3) + 8 * j; const LAS float* s = scr + (8 * c) * 33 + n;
        v4u o; o.x = pk2(s[0 * 33], s[1 * 33]); o.y = pk2(s[2 * 33], s[3 * 33]); o.z = pk2(s[4 * 33], s[5 * 33]); o.w = pk2(s[6 * 33], s[7 * 33]);
        *(v4u*)(WT + (size_t)(n0 + n) * K + k0 + 8 * c) = o; }
    LDS_WAIT(); asm volatile("" ::: "memory");
}

__device__ __forceinline__ void p0_prologue(const Args& A, LAS unsigned char* lds, int vcu, int G) {
    const int tid = threadIdx.x, lane = tid & 63, wave = __builtin_amdgcn_readfirstlane(tid >> 6);
    const int gw = vcu * NWAVES + wave, NGW = G * NWAVES;
    {
        LAS float* scr = (LAS float*)(lds + wave * 16384);
        bf16* WTin = (bf16*)(A.ws + WS_WTIN); bf16* WTout = (bf16*)(A.ws + WS_WTOUT);
        constexpr int I_IN = (D / 64) * (4096 / 32), I_OUT = (D / 64) * (D / 32);
        for (int it = gw; it < I_IN + I_OUT; it += NGW) {
            if (it < I_IN) p0_transpose_item(A.w_in, WIN_LD, D, 4096 / 32, 1536, 8, WTin, scr, it, lane);
            else p0_transpose_item(A.w_out, D, D, D / 32, 1 << 30, 0, WTout, scr, it - I_IN, lane);
        }
    }
    {
        float* LC = (float*)(A.ws + WS_LC); float* TC = (float*)(A.ws + WS_TC);
        for (int ch = gw; ch < NB * 64; ch += NGW) {
            const float* src = A.clf + (size_t)ch * 512 + lane * 8;
            f32x4 a = *(const f32x4*)src, b = *(const f32x4*)(src + 4);
            float v[8] = {a[0], a[1], a[2], a[3], b[0], b[1], b[2], b[3]};
#pragma unroll
            for (int o = 1; o < 64; o <<= 1) {
#pragma unroll
                for (int j = 0; j < 8; ++j) { const float t = __shfl_up(v[j], o); if (lane >= o) v[j] += t; }
            }
            float* dst = LC + (size_t)ch * 512 + lane * 8;
            *(f32x4*)dst = (f32x4){v[0], v[1], v[2], v[3]}; *(f32x4*)(dst + 4) = (f32x4){v[4], v[5], v[6], v[7]};
            if (lane == 63) { float* t = TC + (size_t)ch * 8; *(f32x4*)t = (f32x4){v[0], v[1], v[2], v[3]}; *(f32x4*)(t + 4) = (f32x4){v[4], v[5], v[6], v[7]}; }
        }
    }
    __syncthreads();
    {
        LAS float* wff = (LAS float*)lds;
        LAS float* lfb = (LAS float*)(lds + 32768);
        for (int i = tid; i < 1024 * 8; i += 512) wff[i] = A.w_in[(size_t)(i >> 3) * WIN_LD + 1536 + (i & 7)];
        __syncthreads();
        bf16* H = (bf16*)(A.ws + WS_H); float* LCUM = (float*)(A.ws + WS_LCUM); float* TTOT = (float*)(A.ws + WS_TTOT);
        f32x4 g[4];
#pragma unroll
        for (int j = 0; j < 4; ++j) g[j] = *(const f32x4*)(A.g_pre + 4 * lane + 256 * j);
        const float bfv = A.b_f[lane & 7];
        for (int blk = vcu; blk < MT / 64; blk += G) {
            for (int i = 0; i < 8; ++i) {
                const int rl = wave * 8 + i, row = blk * 64 + rl;
                const float* xr = (row < NP) ? (A.x_p + (size_t)row * D) : (A.x_s + (size_t)(row - NP) * D);
                f32x4 v[4]; float s = 0.f;
#pragma unroll
                for (int j = 0; j < 4; ++j) { v[j] = *(const f32x4*)(xr + 4 * lane + 256 * j); s += (v[j][0] * v[j][0] + v[j][1] * v[j][1]) + (v[j][2] * v[j][2] + v[j][3] * v[j][3]); }
                const float rstd = 1.0f / sqrtf(wave_sum(s) * (1.0f / D) + EPSN);
                float ff[8] = {0.f, 0.f, 0.f, 0.f, 0.f, 0.f, 0.f, 0.f};
                unsigned long long* o8 = (unsigned long long*)(H + (size_t)row * D) + lane;
#pragma unroll
                for (int j = 0; j < 4; ++j) {
                    const f32x4 hv = v[j] * rstd * g[j];
                    o8[64 * j] = (unsigned long long)pk2(hv[0], hv[1]) | ((unsigned long long)pk2(hv[2], hv[3]) << 32);
#pragma unroll
                    for (int e = 0; e < 4; ++e) { const LAS float* wr = wff + (size_t)(256 * j + 4 * lane + e) * 8; const f32x4 w0 = *(const LAS f32x4*)wr, w1 = *(const LAS f32x4*)(wr + 4);
                        ff[0] += hv[e] * w0[0]; ff[1] += hv[e] * w0[1]; ff[2] += hv[e] * w0[2]; ff[3] += hv[e] * w0[3];
                        ff[4] += hv[e] * w1[0]; ff[5] += hv[e] * w1[1]; ff[6] += hv[e] * w1[2]; ff[7] += hv[e] * w1[3]; }
                }
                float z = 0.f;
#pragma unroll
                for (int j = 0; j < 8; ++j) { const float t = wave_sum(ff[j]); z = ((lane & 7) == j) ? t : z; }
                z += bfv;
                const float lf = fminf(z, 0.f) - log1pf(expf(-fabsf(z)));
                if (lane < 8) { lfb[rl * 8 + lane] = lf;
                    if (row < NP) A.out[O_LFP + (size_t)row * 8 + lane] = lf; else A.out[O_LFS + (size_t)(row - NP) * 8 + lane] = lf; }
            }
            __syncthreads();
            if (tid < 8) { float run = 0.f;
                for (int r = 0; r < 64; ++r) { run += lfb[r * 8 + tid]; LCUM[(size_t)(blk * 64 + r) * 8 + tid] = run; }
                TTOT[blk * 8 + tid] = run; }
            __syncthreads();
        }
    }
}

constexpr int AL_K = 0, AL_V = 16384, AL_STG = 0, AL_CK = 65536, AL_WSF = 66048, AL_TOT = 68096, AL_DD = 69184, AL_TAB = 70272, AL_MISC = 73344;

__device__ __forceinline__ s16x4 vtr(const LAS unsigned char* p) { return __builtin_bit_cast(s16x4, __builtin_amdgcn_ds_read_tr16_b64_v4i16((LAS v4i16_t*)p)); }
__device__ __forceinline__ bf16x8 cvt8(const f32x4 a, const f32x4 b) {
    v4u w; w.x = pk2(a[0], a[1]); w.y = pk2(a[2], a[3]); w.z = pk2(b[0], b[1]); w.w = pk2(b[2], b[3]); return __builtin_bit_cast(bf16x8, w); }

struct AttnCtx {
    const bf16 *QF, *KF, *VF, *GF, *DQ, *DK, *DV, *GD; bf16* MIX;
    const float *LCUM, *TTOT, *LC, *TC;
    const float *ck, *cv, *cdk, *cdv;
    const float* subln; float lam; float* stash; const unsigned* nrm; unsigned* flags;
};

template <int KIND>
__device__ __forceinline__ void attn_unit(const AttnCtx& C, int u, LAS unsigned char* lds) {
    constexpr bool FOX = (KIND == 0 || KIND == 2), SAMPLE = (KIND >= 2);
    constexpr int DV = FOX ? 64 : 128, NDB = DV / 32, NMAP = FOX ? 1 : 2, NVC = DV / 64;
    int tid = threadIdx.x; asm volatile("" : "+v"(tid));
    const int lane = tid & 63, r32 = lane & 31, hi = lane >> 5; const int wid = __builtin_amdgcn_readfirstlane(tid >> 6);
    int h, qb = 0, b = 0, NT, qrow, qpos, tref, umap = 0;
    if (KIND == 0) { h = u & 7; qb = 63 - (u >> 3); }
    else if (KIND == 1) { umap = u >> 8; h = u & 3; qb = 63 - ((u & 255) >> 2); }
    else if (KIND == 2) { h = u & 7; b = u >> 3; }
    else { h = u & 3; b = u >> 2; }
    if (!SAMPLE) { NT = 4 * qb + 4; qrow = 256 * qb + 32 * wid + r32; qpos = qrow; tref = 4 * qb; }
    else { NT = 65; qrow = NP + b * 64 + 32 * (wid & 1) + r32; qpos = PAST + 32 * (wid & 1) + r32; tref = 64; }
    const bool compute_wave = SAMPLE ? (wid < 2) : true;
    LAS float* ckt = (LAS float*)(lds + AL_CK); LAS float* wsf = (LAS float*)(lds + AL_WSF) + wid * 64;
    LAS float* tot = (LAS float*)(lds + AL_TOT); LAS float* dd = (LAS float*)(lds + AL_DD); const LAS float* tab = (const LAS float*)(lds + AL_TAB) + h * 192;
    float cq = 0.f;
    if (FOX) {
        __syncthreads();
        for (int c = tid; c < NT; c += 512) { float t;
            if (!SAMPLE) t = C.TTOT[c * 8 + h]; else t = (c < 64) ? C.TC[(size_t)(b * 64 + c) * 8 + h] : C.TTOT[(256 + b) * 8 + h];
            tot[c] = t; }
        __syncthreads();
        if (wid == 0) {
            float loc[4]; float run = 0.f;
#pragma unroll
            for (int j = 0; j < 4; ++j) { const int c = tref - 1 - (4 * lane + j); const float v = (c >= 0) ? tot[c] : 0.f; run += v; loc[j] = run; }
            float incl = run;
#pragma unroll
            for (int o = 1; o < 64; o <<= 1) { const float t = __shfl_up(incl, o); if (lane >= o) incl += t; }
            const float excl = incl - run;
#pragma unroll
            for (int j = 0; j < 4; ++j) { const int c = tref - 1 - (4 * lane + j); if (c >= 0) dd[c] = -(excl + loc[j]); }
            if (lane == 0) { float s = 0.f; dd[tref] = 0.f; for (int c = tref + 1; c < NT; ++c) { s += tot[c - 1]; dd[c] = s; } }
            if (KIND == 0) {
                const float qn2 = __uint_as_float(ldu(C.nrm + h * 2)) + __uint_as_float(ldu(C.nrm + h * 2 + 1)), kn2 = __uint_as_float(ldu(C.nrm + 16 + h * 2)) + __uint_as_float(ldu(C.nrm + 16 + h * 2 + 1));
                const float thr_nat = (SKIP_THR + 2.0f * 1.01f * sqrtf(qn2 * kn2)) * (1.0f / LOG2E);
                const float lq0 = __uint_as_float(ldu((const unsigned*)(C.LCUM + (size_t)(256 * qb) * 8 + h)));
                LDS_WAIT();
                int cnt = 0;
#pragma unroll
                for (int j = 0; j < 4; ++j) { const int c = tref - 1 - (4 * lane + j); if (c >= 0 && (lq0 - dd[c + 1]) <= -thr_nat) ++cnt; }
#pragma unroll
                for (int o = 1; o < 64; o <<= 1) cnt += __shfl_xor(cnt, o);
                if (lane == 0) ((LAS int*)(lds + AL_MISC))[8] = cnt;
            }
        }
        __syncthreads();
        const int qc = SAMPLE ? 64 : (qrow >> 6);
        cq = (dd[qc] + C.LCUM[(size_t)qrow * 8 + h]) * LOG2E;
    }
    int t_start = 0;
    if (KIND == 0) t_start = ((const LAS int*)(lds + AL_MISC))[8];
    const int kkey = (tid & 7) + 8 * (tid >> 6), kc = (tid >> 3) & 7; const int kdst = kc * 1024 + kkey * 16;
    const int map_lo = (KIND == 1) ? umap : 0, map_hi = (KIND == 1) ? umap + 1 : NMAP;
    for (int map = map_lo; map < map_hi; ++map) {
        bf16x8 qr[4];
        { const bf16* qsrc = FOX ? (C.QF + (size_t)qrow * 512 + h * 64) : (C.DQ + (size_t)qrow * 512 + h * 128 + map * 64);
#pragma unroll
          for (int d0 = 0; d0 < 4; ++d0) qr[d0] = *(const bf16x8*)(qsrc + d0 * 16 + hi * 8); }
        f32x16 o[NDB];
#pragma unroll
        for (int d = 0; d < NDB; ++d) o[d] = (f32x16){0.f,0.f,0.f,0.f,0.f,0.f,0.f,0.f,0.f,0.f,0.f,0.f,0.f,0.f,0.f,0.f};
        float m_run = NEGBIG, l_run = 0.f;
        v4u kraw[2]; v4u vraw[NVC][2]; float ckraw = 0.f;
        kraw[0] = (v4u){0,0,0,0}; kraw[1] = (v4u){0,0,0,0};
#pragma unroll
        for (int i = 0; i < NVC; ++i) { vraw[i][0] = (v4u){0,0,0,0}; vraw[i][1] = (v4u){0,0,0,0}; }
        auto stage_load = [&](int t) {
            const bool f32src = SAMPLE && (t < 64);
            if (f32src) {
                const float* kp;
                if (FOX) kp = C.ck + ((size_t)(b * PAST + t * 64 + kkey) * 8 + h) * 64 + kc * 8;
                else kp = C.cdk + ((size_t)(b * PAST + t * 64 + kkey) * 4 + h) * 128 + map * 64 + kc * 8;
                kraw[0] = *(const v4u*)kp; kraw[1] = *(const v4u*)(kp + 4);
#pragma unroll
                for (int i = 0; i < NVC; ++i) { const int idx = tid + 512 * i, vkey = idx / (DV / 8), vc = idx % (DV / 8);
                    const float* vp = FOX ? (C.cv + ((size_t)(b * PAST + t * 64 + vkey) * 8 + h) * 64 + vc * 8) : (C.cdv + ((size_t)(b * PAST + t * 64 + vkey) * 4 + h) * 128 + vc * 8);
                    vraw[i][0] = *(const v4u*)vp; vraw[i][1] = *(const v4u*)(vp + 4); }
            } else {
                const size_t krow = SAMPLE ? (size_t)(NP + b * 64 + kkey) : (size_t)(t * 64 + kkey);
                const bf16* kp = FOX ? (C.KF + krow * 512 + h * 64 + kc * 8) : (C.DK + krow * 512 + h * 128 + map * 64 + kc * 8);
                kraw[0] = *(const v4u*)kp;
#pragma unroll
                for (int i = 0; i < NVC; ++i) { const int idx = tid + 512 * i, vkey = idx / (DV / 8), vc = idx % (DV / 8);
                    const size_t vrow = SAMPLE ? (size_t)(NP + b * 64 + vkey) : (size_t)(t * 64 + vkey);
                    const bf16* vp = FOX ? (C.VF + vrow * 512 + h * 64 + vc * 8) : (C.DV + vrow * 512 + h * 128 + vc * 8);
                    vraw[i][0] = *(const v4u*)vp; }
            }
            if (FOX && tid < 64) {
                float lv;
                if (SAMPLE) lv = (t < 64) ? C.LC[(size_t)(b * PAST + t * 64 + tid) * 8 + h] : C.LCUM[(size_t)(NP + b * 64 + tid) * 8 + h];
                else lv = C.LCUM[(size_t)(t * 64 + tid) * 8 + h];
                ckraw = lv;
            }
        };
        auto stage_write = [&](int t, int buf, int vbuf) {
            const bool f32src = SAMPLE && (t < 64);
            LAS unsigned char* kb = lds + AL_K + buf * 8192; LAS unsigned char* vb = lds + AL_V + vbuf * 16384;
            if (f32src) *(LAS bf16x8*)(kb + kdst) = cvt8(__builtin_bit_cast(f32x4, kraw[0]), __builtin_bit_cast(f32x4, kraw[1])); else *(LAS v4u*)(kb + kdst) = kraw[0];
#pragma unroll
            for (int i = 0; i < NVC; ++i) { const int idx = tid + 512 * i, vkey = idx / (DV / 8), vc = idx % (DV / 8);
                const int vdst = (vc >> 2) * 4096 + (vkey >> 4) * 1024 + (vkey & 15) * 64 + (vc & 3) * 16;
                if (f32src) *(LAS bf16x8*)(vb + vdst) = cvt8(__builtin_bit_cast(f32x4, vraw[i][0]), __builtin_bit_cast(f32x4, vraw[i][1])); else *(LAS v4u*)(vb + vdst) = vraw[i][0]; }
            if (FOX && tid < 64) ckt[buf * 64 + tid] = (dd[t] + ckraw) * LOG2E;
        };
        __syncthreads();
        const bool grpB = (!SAMPLE) && (wid >= 4);
        v4u pw[4]; pw[0] = (v4u){0,0,0,0}; pw[1] = pw[0]; pw[2] = pw[0]; pw[3] = pw[0];
        auto pv_step = [&](int vslot) {
            const LAS unsigned char* vt = lds + AL_V + vslot * 16384;
                const LAS unsigned char* vp = vt + ((lane >> 4) & 1) * 32 + (lane & 3) * 8 + (4 * hi + ((lane & 15) >> 2)) * 64;
#pragma unroll
                for (int d = 0; d < NDB; ++d)
#pragma unroll
                    for (int ks = 0; ks < 4; ++ks) {
                        const s16x4 lo = vtr(vp + d * 4096 + ks * 1024), hh = vtr(vp + d * 4096 + ks * 1024 + 512);
                        const bf16x8 vf = (bf16x8){lo[0], lo[1], lo[2], lo[3], hh[0], hh[1], hh[2], hh[3]};
                        o[d] = __builtin_amdgcn_mfma_f32_32x32x16_bf16(__builtin_bit_cast(bf16x8, pw[ks]), vf, o[d], 0, 0, 0);
                        if (ks == 3) __builtin_amdgcn_sched_barrier(0);
                    }
        };
        int vs_prev = 0, vs_cur = 0, vs_next = 1;
        stage_load(t_start); stage_write(t_start, t_start & 1, 0);
        __syncthreads();
        for (int t = t_start; t < NT; ++t) {
            const int buf = t & 1;
            if (t + 1 < NT) stage_load(t + 1);
            if (compute_wave) {
                if (grpB && t > t_start) pv_step(vs_prev);
                {
                const LAS unsigned char* kt = lds + AL_K + buf * 8192;
                f32x16 p0, p1;
                if (FOX) {
#pragma unroll
                    for (int gq = 0; gq < 4; ++gq) { const f32x4 a = *(const LAS f32x4*)(ckt + buf * 64 + 8 * gq + 4 * hi), bq = *(const LAS f32x4*)(ckt + buf * 64 + 32 + 8 * gq + 4 * hi);
#pragma unroll
                        for (int e = 0; e < 4; ++e) { p0[4 * gq + e] = cq - a[e]; p1[4 * gq + e] = cq - bq[e]; } }
                } else {
                    const bool far_t = SAMPLE ? (t <= 61) : (t <= 4 * qb - 3);
                    const float c15 = far_t ? tab[0] : 0.f;
#pragma unroll
                    for (int r = 0; r < 16; ++r) { p0[r] = c15; p1[r] = c15; }
                }
                const LAS unsigned char* kbp = kt + hi * 1024 + r32 * 16;
#pragma unroll
                for (int d0 = 0; d0 < 4; ++d0) {
                    const bf16x8 b0 = *(const LAS bf16x8*)(kbp + d0 * 2048), b1 = *(const LAS bf16x8*)(kbp + d0 * 2048 + 512);
                    p0 = __builtin_amdgcn_mfma_f32_32x32x16_bf16(b0, qr[d0], p0, 0, 0, 0);
                    p1 = __builtin_amdgcn_mfma_f32_32x32x16_bf16(b1, qr[d0], p1, 0, 0, 0);
                }
                if (!FOX) {
                    const bool far_t = SAMPLE ? (t <= 61) : (t <= 4 * qb - 3);
#ifndef T_NONEAR
                    if (!far_t) {
#pragma unroll
                        for (int r = 0; r < 16; ++r) { const int rel0 = t * 64 + crow(r, hi) - qpos; int i0 = rel0 < -128 ? -128 : rel0; i0 = i0 > 63 ? 63 : i0; int i1 = rel0 + 32 < -128 ? -128 : rel0 + 32; i1 = i1 > 63 ? 63 : i1;
                            p0[r] += tab[i0 + 128]; p1[r] += tab[i1 + 128]; }
                    }
#endif
                    if (!SAMPLE) { if (t > (qpos >> 6)) {
#pragma unroll
                        for (int r = 0; r < 16; ++r) { p0[r] = NEGBIG; p1[r] = NEGBIG; } } }
                } else {
                    const bool band = SAMPLE ? (t == 64) : (t >= 4 * qb);
                    if (band) { const int kb0 = (SAMPLE ? PAST : t * 64);
#pragma unroll
                        for (int r = 0; r < 16; ++r) { const int kv = kb0 + crow(r, hi); if (kv > qpos) p0[r] = NEGBIG; if (kv + 32 > qpos) p1[r] = NEGBIG; } }
                }
                float rm = fmaxf(p0[0], p1[0]);
#pragma unroll
                for (int r = 1; r < 16; ++r) rm = fmaxf(rm, fmaxf(p0[r], p1[r]));
                rm = fmaxf(rm, __shfl_xor(rm, 32));
                if (__any(rm > m_run + RESC_THR)) {
                    const float m_new = fmaxf(m_run, rm); const float alpha = __builtin_amdgcn_exp2f(m_run - m_new); m_run = m_new;
                    l_run *= alpha;
                    if (hi == 0) wsf[r32] = alpha;
#pragma unroll
                    for (int gq = 0; gq < 4; ++gq) { const f32x4 a = *(const LAS f32x4*)(wsf + 8 * gq + 4 * hi);
#pragma unroll
                        for (int d = 0; d < NDB; ++d)
#pragma unroll
                            for (int e = 0; e < 4; ++e) o[d][4 * gq + e] *= a[e]; }
                }
                float rs = 0.f;
#pragma unroll
                for (int r = 0; r < 16; ++r) { p0[r] = __builtin_amdgcn_exp2f(p0[r] - m_run); p1[r] = __builtin_amdgcn_exp2f(p1[r] - m_run); rs += p0[r] + p1[r]; }
                l_run += rs;
                pw[0] = (v4u){pk2(p0[0], p0[1]), pk2(p0[2], p0[3]), pk2(p0[4], p0[5]), pk2(p0[6], p0[7])};
                pw[1] = (v4u){pk2(p0[8], p0[9]), pk2(p0[10], p0[11]), pk2(p0[12], p0[13]), pk2(p0[14], p0[15])};
                pw[2] = (v4u){pk2(p1[0], p1[1]), pk2(p1[2], p1[3]), pk2(p1[4], p1[5]), pk2(p1[6], p1[7])};
                pw[3] = (v4u){pk2(p1[8], p1[9]), pk2(p1[10], p1[11]), pk2(p1[12], p1[13]), pk2(p1[14], p1[15])};
                }
                if (!grpB) pv_step(vs_cur);
            }
            if (t + 1 < NT) stage_write(t + 1, buf ^ 1, vs_next);
            __syncthreads();
            vs_prev = vs_cur; vs_cur = vs_next; vs_next = (vs_next == 2) ? 0 : vs_next + 1;
        }
        if (grpB) pv_step(vs_prev);
        __syncthreads();
        if (compute_wave) {
            int tidf = threadIdx.x; asm volatile("" : "+v"(tidf));
            const int lanef = tidf & 63;
            float lt = l_run + __shfl_xor(l_run, 32);
            const float inv = 1.0f / lt;
            if (hi == 0) wsf[r32] = inv;
            float rinv[16];
#pragma unroll
            for (int gq = 0; gq < 4; ++gq) { const f32x4 a = *(const LAS f32x4*)(wsf + 8 * gq + 4 * hi); rinv[4 * gq] = a[0]; rinv[4 * gq + 1] = a[1]; rinv[4 * gq + 2] = a[2]; rinv[4 * gq + 3] = a[3]; }
            const int rowb = SAMPLE ? (NP + b * 64 + 32 * (wid & 1)) : (256 * qb + 32 * wid);
            if (!FOX && map == 0) {
                const size_t slot = (KIND == 1) ? (size_t)(256 + (u & 255)) : (size_t)blockIdx.x;
                f32x4* st = (f32x4*)(C.stash + (slot * 512 + tidf) * (NDB * 16));
#pragma unroll
                for (int d = 0; d < NDB; ++d)
#pragma unroll
                    for (int gq = 0; gq < 4; ++gq) st[d * 4 + gq] = (f32x4){o[d][4 * gq] * rinv[4 * gq], o[d][4 * gq + 1] * rinv[4 * gq + 1], o[d][4 * gq + 2] * rinv[4 * gq + 2], o[d][4 * gq + 3] * rinv[4 * gq + 3]};
                if (KIND == 1) {
                    asm volatile("s_waitcnt vmcnt(0)" ::: "memory");
                    __syncthreads();
                    if (tidf == 0) { __builtin_amdgcn_fence(__ATOMIC_RELEASE, "agent"); asm volatile("s_waitcnt vmcnt(0)" ::: "memory");
                        __hip_atomic_store(C.flags + 16 * (u & 255), 1u, __ATOMIC_RELAXED, __HIP_MEMORY_SCOPE_AGENT); }
                }
            } else {
                LAS bf16* stg = (LAS bf16*)(lds + AL_STG) + wid * (32 * DV);
                if (FOX) {
#pragma unroll
                    for (int d = 0; d < NDB; ++d)
#pragma unroll
                        for (int r = 0; r < 16; ++r) stg[crow(r, hi) * DV + 32 * d + r32] = (bf16)f2bf(o[d][r] * rinv[r]);
                } else {
                    const size_t slot = (KIND == 1) ? (size_t)(256 + (u & 255)) : (size_t)blockIdx.x;
                    if (KIND == 1) {
                        if (tidf == 0) { unsigned sp = 0; while (__hip_atomic_load(C.flags + 16 * (u & 255), __ATOMIC_RELAXED, __HIP_MEMORY_SCOPE_AGENT) == 0u) { __builtin_amdgcn_s_sleep(8); if (++sp > (1u << 22)) break; }
                            __builtin_amdgcn_fence(__ATOMIC_ACQUIRE, "agent"); asm volatile("s_waitcnt vmcnt(0)" ::: "memory"); }
                        __syncthreads();
                    }
                    const f32x4* st = (const f32x4*)(C.stash + (slot * 512 + tidf) * (NDB * 16));
#pragma unroll
                    for (int d = 0; d < NDB; ++d)
#pragma unroll
                        for (int gq = 0; gq < 4; ++gq) { const f32x4 s1 = st[d * 4 + gq];
#pragma unroll
                            for (int e = 0; e < 4; ++e) { const int r = 4 * gq + e; stg[crow(r, hi) * DV + 32 * d + r32] = (bf16)f2bf(s1[e] - C.lam * (o[d][r] * rinv[r])); } }
                }
                LDS_WAIT(); asm volatile("" ::: "memory");
                constexpr int LPR = DV / 8;
                constexpr int RPP = 64 / LPR;
                const int cl = lanef % LPR;
#pragma unroll
                for (int ps = 0; ps < 32 / RPP; ++ps) {
                    const int rl = ps * RPP + lanef / LPR; const size_t row = (size_t)(rowb + rl);
                    const v4u sv = *(const LAS v4u*)(stg + rl * DV + cl * 8);
                    float xv[8];
                    xv[0] = __builtin_bit_cast(float, sv.x << 16); xv[1] = __builtin_bit_cast(float, sv.x & 0xffff0000u); xv[2] = __builtin_bit_cast(float, sv.y << 16); xv[3] = __builtin_bit_cast(float, sv.y & 0xffff0000u);
                    xv[4] = __builtin_bit_cast(float, sv.z << 16); xv[5] = __builtin_bit_cast(float, sv.z & 0xffff0000u); xv[6] = __builtin_bit_cast(float, sv.w << 16); xv[7] = __builtin_bit_cast(float, sv.w & 0xffff0000u);
                    const bf16* gp = FOX ? (C.GF + row * 512 + h * 64 + cl * 8) : (C.GD + row * 512 + h * 128 + cl * 8);
                    const v4u gv = *(const v4u*)gp;
                    float gg[8];
                    gg[0] = __builtin_bit_cast(float, gv.x << 16); gg[1] = __builtin_bit_cast(float, gv.x & 0xffff0000u); gg[2] = __builtin_bit_cast(float, gv.y << 16); gg[3] = __builtin_bit_cast(float, gv.y & 0xffff0000u);
                    gg[4] = __builtin_bit_cast(float, gv.z << 16); gg[5] = __builtin_bit_cast(float, gv.z & 0xffff0000u); gg[6] = __builtin_bit_cast(float, gv.w << 16); gg[7] = __builtin_bit_cast(float, gv.w & 0xffff0000u);
                    if (!FOX) {
                        float sq = 0.f;
#pragma unroll
                        for (int e = 0; e < 8; ++e) sq += xv[e] * xv[e];
#pragma unroll
                        for (int s = 1; s < LPR; s <<= 1) sq += __shfl_xor(sq, s);
                        const float rs = (1.0f / sqrtf(sq * (1.0f / 128.0f) + EPSN)) * 0.8f;
                        const f32x4 s0 = *(const f32x4*)(C.subln + cl * 8), s1 = *(const f32x4*)(C.subln + cl * 8 + 4);
#pragma unroll
                        for (int e = 0; e < 4; ++e) { xv[e] *= rs * s0[e]; xv[4 + e] *= rs * s1[e]; }
                    }
                    v4u ov; ov.x = pk2(xv[0] * gg[0], xv[1] * gg[1]); ov.y = pk2(xv[2] * gg[2], xv[3] * gg[3]); ov.z = pk2(xv[4] * gg[4], xv[5] * gg[5]); ov.w = pk2(xv[6] * gg[6], xv[7] * gg[7]);
                    bf16* op = FOX ? (C.MIX + row * 1024 + h * 64 + cl * 8) : (C.MIX + row * 1024 + 512 + h * 128 + cl * 8);
                    *(v4u*)op = ov;
                }
            }
        }
    }
}

template <int KIND>
__device__ __forceinline__ void attn_queue(const AttnCtx& C, unsigned* head, int nunits, LAS unsigned char* lds) {
    volatile LAS unsigned* slot = (volatile LAS unsigned*)(lds + AL_MISC);
    for (;;) {
        __syncthreads();
        if (threadIdx.x == 0) slot[0] = __hip_atomic_fetch_add(head, 1u, __ATOMIC_RELAXED, __HIP_MEMORY_SCOPE_AGENT);
        __syncthreads();
        const unsigned u = slot[0];
        if (u >= (unsigned)nunits) break;
        attn_unit<KIND>(C, (int)u, lds);
    }
}

__device__ __forceinline__ int t5_bucket(int rel) {
    const int n = rel < 0 ? -rel : rel; int bk;
    if (n < 8) bk = n; else bk = n < 12 ? 8 : n < 16 ? 9 : n < 23 ? 10 : n < 32 ? 11 : n < 46 ? 12 : n < 64 ? 13 : n < 91 ? 14 : 15;
    return bk + (rel > 0 ? 16 : 0);
}

__global__ void __launch_bounds__(NWAVES * 64, LBW) fwd_kernel(Args A) {
    extern __shared__ __attribute__((aligned(16))) unsigned char lds_raw[];
    LAS unsigned char* lds = (LAS unsigned char*)lds_raw;
    const int tid = threadIdx.x, lane = tid & 63; const int wave = __builtin_amdgcn_readfirstlane(tid >> 6);
    const int G = gridDim.x; const int bx = blockIdx.x; const int vcu = (G % 8 == 0) ? (bx % 8) * (G / 8) + bx / 8 : bx;
    volatile LAS unsigned* MISC = (volatile LAS unsigned*)(lds + MISC_OFF);
    for (int i = tid; i < (LDS_BYTES - MISC_OFF) / 4; i += NWAVES * 64) MISC[i] = 0u;
    __syncthreads();
    unsigned* ctl = (unsigned*)(A.ws + WS_CTL);
    XcdBarrier bar = xcd_barrier_post(ctl + CW_BAR, MISC + 8);

    p0_prologue(A, lds, vcu, G);
#ifdef PROBE_P0
    __syncthreads(); p0_prologue(A, lds, vcu, G);
#endif
    xcd_barrier(bar);

    {
        pg8::Gemm g{(const pg8::bf16_t*)(A.ws + WS_H), (const pg8::bf16_t*)(A.ws + WS_WTIN), MT, 4096, D};
        pg8::StaticOrder S; S.init(MT, 4096, G, bx);
        pg8::EpiIn E{(pg8::bf16_t*)(A.ws + WS_SEG), SEG_BYTES / 2, A.out, C2, ctl + CW_NRM};
        pg8::gemm_phase<pg8::EpiIn, pg8::StaticOrder, true, true>(lds, g, S, E);
#ifdef PROBE_P1
        __syncthreads(); pg8::gemm_phase<pg8::EpiIn, pg8::StaticOrder, true, true>(lds, g, S, E);
#endif
    }
    xcd_barrier(bar);

    {
        AttnCtx C;
        C.QF = (const bf16*)(A.ws + WS_SEG); C.KF = C.QF + SEG_BYTES / 2; C.VF = C.KF + SEG_BYTES / 2; C.GF = C.VF + SEG_BYTES / 2;
        C.DQ = C.GF + SEG_BYTES / 2; C.DK = C.DQ + SEG_BYTES / 2; C.DV = C.DK + SEG_BYTES / 2; C.GD = C.DV + SEG_BYTES / 2;
        C.MIX = (bf16*)(A.ws + WS_H);
        C.LCUM = (const float*)(A.ws + WS_LCUM); C.TTOT = (const float*)(A.ws + WS_TTOT); C.LC = (const float*)(A.ws + WS_LC); C.TC = (const float*)(A.ws + WS_TC);
        C.ck = A.ck; C.cv = A.cv; C.cdk = A.cdk; C.cdv = A.cdv; C.subln = A.subln; C.stash = (float*)(A.ws + WS_STASH); C.nrm = ctl + CW_NRM; C.flags = ctl + CW_FLAGS;
        LAS float* tabw = (LAS float*)(lds + AL_TAB); LAS float* misc = (LAS float*)(lds + AL_MISC);
        if (wave == 0) {
            const float a = wave_sum(A.lq1[lane] * A.lk1[lane]), c = wave_sum(A.lq2[lane] * A.lk2[lane]);
            if (lane == 0) misc[4] = expf(a) - expf(c) + 0.2f;
        }
        for (int i = tid; i < 4 * 192; i += 512) { const int hh = i / 192, rel = (i % 192) - 128; tabw[i] = A.relb[t5_bucket(rel) * 4 + hh] * LOG2E; }
        __syncthreads();
        C.lam = misc[4];
#ifndef NO_K1
        attn_queue<1>(C, ctl + CW_Q0, 512, lds);
#endif
#ifdef PROBE_PD2
        attn_queue<1>(C, ctl + 768, 512, lds);
#endif
#ifdef PROBE_S2
        attn_queue<3>(C, ctl + 832, 128, lds);
        attn_queue<2>(C, ctl + 896, 256, lds);
#endif
#ifndef NO_K3
        attn_queue<3>(C, ctl + CW_Q1, 128, lds);
#endif
#ifndef NO_K2
        attn_queue<2>(C, ctl + CW_Q2, 256, lds);
#endif
#ifndef NO_K0
        attn_queue<0>(C, ctl + CW_Q3, 512, lds);
#endif
#ifdef PROBE_PF2
        attn_queue<0>(C, ctl + 960, 512, lds);
#endif
    }
    xcd_barrier(bar);

    {
        pg8::Gemm g{(const pg8::bf16_t*)(A.ws + WS_H), (const pg8::bf16_t*)(A.ws + WS_WTOUT), MT, D, D};
        pg8::StaticOrder S; S.init(MT, D, G, bx);
        pg8::EpiOut E{(float*)(A.ws + WS_OUTF), (float*)(A.ws + WS_SS)};
        pg8::gemm_phase<pg8::EpiOut, pg8::StaticOrder, true, true>(lds, g, S, E);
#ifdef PROBE_P3
        __syncthreads(); pg8::gemm_phase<pg8::EpiOut, pg8::StaticOrder, true, true>(lds, g, S, E);
#endif
    }
    xcd_barrier(bar);

    {
        const float* OUTF = (const float*)(A.ws + WS_OUTF); const float* SS = (const float*)(A.ws + WS_SS);
        const int gw = vcu * NWAVES + wave, NGW = G * NWAVES;
        f32x4 g[4];
#pragma unroll
        for (int j = 0; j < 4; ++j) g[j] = *(const f32x4*)(A.g_post + 4 * lane + 256 * j);
        for (int row = gw; row < MT; row += NGW) {
            const float sv = (lane < 16) ? SS[(size_t)row * 16 + lane] : 0.f;
            const float rstd = 1.0f / sqrtf(wave_sum(sv) * (1.0f / D) + EPSN);
            const float* xr = (row < NP) ? (A.x_p + (size_t)row * D) : (A.x_s + (size_t)(row - NP) * D);
            const float* orow = OUTF + (size_t)row * D; float* yr = A.out + (size_t)row * D;
#pragma unroll
            for (int j = 0; j < 4; ++j) { const f32x4 xv = *(const f32x4*)(xr + 4 * lane + 256 * j), ov = *(const f32x4*)(orow + 4 * lane + 256 * j);
                *(f32x4*)(yr + 4 * lane + 256 * j) = xv + ov * rstd * g[j]; }
        }
    }
}

extern "C" void kernel_launch(void* const* d_in, const int* in_sizes, int n_in, void* d_out, int out_size, void* d_ws, size_t ws_size, hipStream_t stream) {
    static int grid = 0;
    if (grid == 0) {
        if (n_in != 18 || in_sizes[0] != NP * D || (size_t)out_size != O_TOTAL || ws_size < WS_END) {
            fprintf(stderr, "kernel_launch: unexpected shapes: n_in %d in0 %d out %d ws %zu; nothing launched\n", n_in, n_in > 0 ? in_sizes[0] : -1, out_size, ws_size); grid = -1; return; }
        int dev = 0, cus = 0, per_cu = 0;
        if (hipGetDevice(&dev) != hipSuccess || hipDeviceGetAttribute(&cus, hipDeviceAttributeMultiprocessorCount, dev) != hipSuccess) { grid = -1; return; }
        if (hipFuncSetAttribute((const void*)fwd_kernel, hipFuncAttributeMaxDynamicSharedMemorySize, LDS_BYTES) != hipSuccess) { fprintf(stderr, "kernel_launch: hipFuncSetAttribute failed\n"); grid = -1; return; }
        if (hipOccupancyMaxActiveBlocksPerMultiprocessor(&per_cu, (const void*)fwd_kernel, NWAVES * 64, LDS_BYTES) != hipSuccess || per_cu < 1) {
            fprintf(stderr, "kernel_launch: occupancy query says %d blocks per CU; nothing launched\n", per_cu); (void)hipGetLastError(); grid = -1; return; }
        grid = cus;
    }
    if (grid < 0) return;
    (void)hipMemsetAsync((char*)d_ws + WS_CTL, 0, CTL_ZERO_BYTES, stream);
    Args a{};
    a.x_p = (const float*)d_in[0]; a.x_s = (const float*)d_in[1]; a.ck = (const float*)d_in[2]; a.cv = (const float*)d_in[3]; a.clf = (const float*)d_in[4];
    a.cdk = (const float*)d_in[5]; a.cdv = (const float*)d_in[6]; a.g_pre = (const float*)d_in[7]; a.w_in = (const float*)d_in[8]; a.b_f = (const float*)d_in[9];
    a.lq1 = (const float*)d_in[10]; a.lk1 = (const float*)d_in[11]; a.lq2 = (const float*)d_in[12]; a.lk2 = (const float*)d_in[13]; a.subln = (const float*)d_in[14];
    a.w_out = (const float*)d_in[15]; a.g_post = (const float*)d_in[16]; a.relb = (const float*)d_in[17];
    a.out = (float*)d_out; a.ws = (unsigned char*)d_ws;
    hipLaunchKernelGGL(fwd_kernel, dim3(grid), dim3(NWAVES * 64), LDS_BYTES, stream, a);
    const hipError_t le = hipPeekAtLastError();
    if (le != hipSuccess) fprintf(stderr, "kernel_launch: launch failed: %s\n", hipGetErrorName(le));
}
```
